# Optimizing an MI355X kernel written in HIP

```python
import jax, jax.numpy as jnp
from jax import lax
import numpy as np

D_MODEL = 1024
BATCH = 4
SEQ = 8192
DEPTH = 1

MLSTM_HEADS = 4
MLSTM_DV = D_MODEL // MLSTM_HEADS
MLSTM_DQK = MLSTM_DV // 2
MLSTM_CHUNK = 64
CONV_K = 4
NSA_DH = 64
NSA_HEADS = (D_MODEL // 2) // NSA_DH
NSA_KV_GROUPS = 2
NSA_HPG = NSA_HEADS // NSA_KV_GROUPS
CMP_BLOCK = 32
CMP_STRIDE = 16
CMP_HIDDEN = 256
SLC_BLOCK = 64
SLC_TOPN = 16
WINDOW = 512
NSA_QBLOCK = 128
FFN_HIDDEN = ((8 * D_MODEL + 3 * 256 - 1) // (3 * 256)) * 256
RMS_EPS = 1e-6
NEG_INF = -1e30
SEL_BIG = 1e9

M_QK = MLSTM_HEADS * MLSTM_DQK
M_V = MLSTM_HEADS * MLSTM_DV
N_Q = NSA_HEADS * NSA_DH
N_KV = NSA_KV_GROUPS * NSA_DH
IN_SPLITS = (2 * M_QK, M_V, M_V, MLSTM_HEADS, MLSTM_HEADS, N_Q, 6 * N_KV, 3 * NSA_HEADS, D_MODEL, D_MODEL)
IN_WIDTH = sum(IN_SPLITS)

kernel_name = 'hybrid_mlstm_nsa_block'


def rms_norm(x, g):
    xf = x.astype(jnp.float32)
    y = xf * lax.rsqrt(jnp.mean(xf * xf, axis=-1, keepdims=True) + RMS_EPS)
    return (y * g.astype(jnp.float32)).astype(x.dtype)


def masked_softmax(s, mask):
    s = jnp.where(mask, s.astype(jnp.float32), NEG_INF)
    return jnp.where(mask, jax.nn.softmax(s, axis=-1), 0.0)


def causal_conv(x, w, b):
    c = x.shape[-1]
    y = lax.conv_general_dilated(x, w[:, None, :], window_strides=(1,), padding=[(CONV_K - 1, 0)],
                                 dimension_numbers=('NWC', 'WIO', 'NWC'), feature_group_count=c)
    return y + b


def mlstm_chunkwise(q, k, v, log_i, log_f):
    B, H, S, DK = q.shape
    DV = v.shape[-1]
    L = MLSTM_CHUNK
    nc = S // L

    def chunks(a):
        return jnp.moveaxis(a.reshape(B, H, nc, L, *a.shape[3:]), 2, 0)

    causal = jnp.tril(jnp.ones((L, L), dtype=bool))

    def step(carry, inp):
        C, n, m = carry
        qc, kc, vc, ic, fc = inp
        b = jnp.cumsum(fc, axis=-1)
        d_intra = jnp.where(causal, b[..., :, None] - b[..., None, :] + ic[..., None, :], -jnp.inf)
        d_inter = b + m[..., None]
        m_t = jnp.maximum(d_inter, jnp.max(d_intra, axis=-1))
        w_intra = jnp.exp(d_intra - m_t[..., None])
        w_inter = jnp.exp(d_inter - m_t)
        s = jnp.einsum('bhld,bhsd->bhls', qc, kc) * w_intra
        num = jnp.einsum('bhls,bhsv->bhlv', s, vc) + w_inter[..., None] * jnp.einsum('bhld,bhvd->bhlv', qc, C)
        nq = jnp.sum(s, axis=-1) + w_inter * jnp.einsum('bhld,bhd->bhl', qc, n)
        h = num / jnp.maximum(jnp.abs(nq), jnp.exp(-m_t))[..., None]
        b_last = b[..., -1]
        d_state = b_last[..., None] - b + ic
        m_new = jnp.maximum(b_last + m, jnp.max(d_state, axis=-1))
        w_state = jnp.exp(d_state - m_new[..., None])
        decay = jnp.exp(b_last + m - m_new)
        C_new = decay[..., None, None] * C + jnp.einsum('bhsv,bhsd->bhvd', vc * w_state[..., None], kc)
        n_new = decay[..., None] * n + jnp.einsum('bhs,bhsd->bhd', w_state, kc)
        return (C_new, n_new, m_new), h

    init = (jnp.zeros((B, H, DV, DK), jnp.float32), jnp.zeros((B, H, DK), jnp.float32), jnp.zeros((B, H), jnp.float32))
    _, h = lax.scan(step, init, (chunks(q), chunks(k), chunks(v), chunks(log_i), chunks(log_f)))
    return jnp.moveaxis(h, 0, 2).reshape(B, H, S, DV)


def mlstm_branch(qk, v, o, i_pre, f_pre, f_bias, conv_w, conv_b, norm_g):
    B, S, _ = v.shape
    qk = jax.nn.silu(causal_conv(qk, conv_w, conv_b))
    q, k = jnp.split(qk, 2, axis=-1)

    def heads(a, d):
        return a.reshape(B, S, MLSTM_HEADS, d).transpose(0, 2, 1, 3).astype(jnp.float32)

    q = heads(q, MLSTM_DQK)
    k = heads(k, MLSTM_DQK) * (MLSTM_DQK ** -0.5)
    vh = heads(v, MLSTM_DV)
    log_i = i_pre.astype(jnp.float32).transpose(0, 2, 1)
    log_f = jax.nn.log_sigmoid((f_pre + f_bias).astype(jnp.float32)).transpose(0, 2, 1)
    h = mlstm_chunkwise(q, k, vh, log_i, log_f).transpose(0, 2, 1, 3)
    h = rms_norm(h, norm_g.reshape(MLSTM_HEADS, MLSTM_DV))
    h = jax.nn.sigmoid(o.astype(jnp.float32)).reshape(B, S, MLSTM_HEADS, MLSTM_DV) * h
    return h.reshape(B, S, M_V).astype(v.dtype)


def compress_blocks(tok, pos_emb, w1, w2):
    B, S, G, dh = tok.shape
    n_cmp = (S - CMP_BLOCK) // CMP_STRIDE + 1
    idx = np.arange(n_cmp)[:, None] * CMP_STRIDE + np.arange(CMP_BLOCK)[None, :]
    blocks = tok[:, idx] + pos_emb[None, None, :, None, :]
    blocks = blocks.transpose(0, 1, 3, 2, 4).reshape(B, n_cmp, G, CMP_BLOCK * dh)
    return jax.nn.silu(blocks @ w1) @ w2


def nsa_branch(q, g_br, kv, cmp_k_pos, cmp_k_w1, cmp_k_w2, cmp_v_pos, cmp_v_w1, cmp_v_w2):
    B, S, _ = q.shape
    G, HPG, dh, Qb = NSA_KV_GROUPS, NSA_HPG, NSA_DH, NSA_QBLOCK
    k_cmp, v_cmp, k_slc, v_slc, k_win, v_win = [a.reshape(B, S, G, dh) for a in jnp.split(kv, 6, axis=-1)]
    kc = compress_blocks(k_cmp, cmp_k_pos, cmp_k_w1, cmp_k_w2)
    vc = compress_blocks(v_cmp, cmp_v_pos, cmp_v_w1, cmp_v_w2)
    n_cmp = kc.shape[1]
    cmp_end = jnp.arange(n_cmp) * CMP_STRIDE + CMP_BLOCK - 1
    n_slc = S // SLC_BLOCK
    n_sel = min(SLC_TOPN, n_slc)
    ratio, span = SLC_BLOCK // CMP_STRIDE, CMP_BLOCK // CMP_STRIDE
    offs = (np.arange(ratio)[:, None] - np.arange(span)[None, :]).reshape(-1)
    map_idx = np.arange(n_slc)[:, None] * ratio + offs[None, :]
    map_valid = (map_idx >= 0) & (map_idx < n_cmp)
    map_idx = np.clip(map_idx, 0, n_cmp - 1)
    ks_blocks = k_slc.reshape(B, n_slc, SLC_BLOCK, G, dh).transpose(0, 3, 1, 2, 4)
    vs_blocks = v_slc.reshape(B, n_slc, SLC_BLOCK, G, dh).transpose(0, 3, 1, 2, 4)
    kw_pad = jnp.pad(k_win, ((0, 0), (WINDOW, 0), (0, 0), (0, 0)))
    vw_pad = jnp.pad(v_win, ((0, 0), (WINDOW, 0), (0, 0), (0, 0)))
    bi = jnp.arange(B)[:, None, None, None]
    gi = jnp.arange(G)[None, None, :, None]
    blk = jnp.arange(n_slc)
    scale = dh ** -0.5

    def block_fn(args):
        qb, gb, q0 = args
        t = q0 + jnp.arange(Qb)
        qg = qb.reshape(B, Qb, G, HPG, dh) * scale
        s = jnp.einsum('bqghd,bcgd->bqghc', qg, kc)
        mask_c = (cmp_end[None, :] <= t[:, None])[None, :, None, None, :]
        p_c = masked_softmax(s, mask_c)
        o_cmp = jnp.einsum('bqghc,bcgd->bqghd', p_c.astype(vc.dtype), vc)
        imp = jnp.sum(p_c, axis=3)
        imp = jnp.sum(jnp.where(map_valid, imp[..., map_idx], 0.0), axis=-1)
        cur = t // SLC_BLOCK
        eligible = blk[None, :] <= cur[:, None]
        forced = (blk[None, :] == 0) | (blk[None, :] == cur[:, None]) | (blk[None, :] == cur[:, None] - 1)
        score = jnp.where(forced[None, :, None, :], SEL_BIG, jnp.where(eligible[None, :, None, :], imp, -SEL_BIG))
        _, idx = lax.top_k(score, n_sel)
        kg = ks_blocks[bi, gi, idx]
        vg = vs_blocks[bi, gi, idx]
        pos = idx[..., None] * SLC_BLOCK + jnp.arange(SLC_BLOCK)
        mask_s = (pos <= t[None, :, None, None, None]).reshape(B, Qb, G, 1, n_sel * SLC_BLOCK)
        s = jnp.einsum('bqghd,bqgnrd->bqghnr', qg, kg).reshape(B, Qb, G, HPG, n_sel * SLC_BLOCK)
        p_s = masked_softmax(s, mask_s).reshape(B, Qb, G, HPG, n_sel, SLC_BLOCK)
        o_slc = jnp.einsum('bqghnr,bqgnrd->bqghd', p_s.astype(vg.dtype), vg)
        kw = lax.dynamic_slice_in_dim(kw_pad, q0, Qb + WINDOW, axis=1)
        vw = lax.dynamic_slice_in_dim(vw_pad, q0, Qb + WINDOW, axis=1)
        kpos = q0 - WINDOW + jnp.arange(Qb + WINDOW)
        mask_w = ((kpos[None, :] <= t[:, None]) & (kpos[None, :] > t[:, None] - WINDOW) & (kpos[None, :] >= 0))[None, :, None, None, :]
        s = jnp.einsum('bqghd,bkgd->bqghk', qg, kw)
        p_w = masked_softmax(s, mask_w)
        o_win = jnp.einsum('bqghk,bkgd->bqghd', p_w.astype(vw.dtype), vw)
        gates = jax.nn.sigmoid(gb.astype(jnp.float32)).reshape(B, Qb, G, HPG, 3).astype(o_cmp.dtype)
        o = gates[..., 0:1] * o_cmp + gates[..., 1:2] * o_slc + gates[..., 2:3] * o_win
        return o.reshape(B, Qb, N_Q)

    n_qb = S // Qb
    q_blocks = q.reshape(B, n_qb, Qb, N_Q).transpose(1, 0, 2, 3)
    g_blocks = g_br.reshape(B, n_qb, Qb, 3 * NSA_HEADS).transpose(1, 0, 2, 3)
    starts = jnp.arange(n_qb, dtype=jnp.int32) * Qb
    out = lax.map(block_fn, (q_blocks, g_blocks, starts))
    return out.transpose(1, 0, 2, 3).reshape(B, S, N_Q)


def setup_inputs(seed: int = 0) -> dict:
    key = jax.random.key(seed)
    ks = jax.random.split(key, 24)

    def nrm(k, shape, scale):
        return jax.random.normal(k, shape, jnp.float32) * scale

    ph = CMP_BLOCK * NSA_DH
    return {
        'x': nrm(ks[0], (BATCH, SEQ, D_MODEL), 1.0),
        'norm1_g': 1.0 + nrm(ks[1], (DEPTH, D_MODEL), 0.02),
        'w_in': nrm(ks[2], (DEPTH, D_MODEL, IN_WIDTH), D_MODEL ** -0.5),
        'b_in': nrm(ks[3], (DEPTH, IN_WIDTH), 0.02),
        'f_bias': jnp.linspace(3.0, 6.0, MLSTM_HEADS, dtype=jnp.float32)[None, :] + nrm(ks[4], (DEPTH, MLSTM_HEADS), 0.1),
        'conv_w': nrm(ks[5], (DEPTH, CONV_K, 2 * M_QK), CONV_K ** -0.5),
        'conv_b': nrm(ks[6], (DEPTH, 2 * M_QK), 0.02),
        'mlstm_norm_g': 1.0 + nrm(ks[7], (DEPTH, M_V), 0.02),
        'cmp_k_pos': nrm(ks[8], (DEPTH, CMP_BLOCK, NSA_DH), 0.02),
        'cmp_k_w1': nrm(ks[9], (DEPTH, ph, CMP_HIDDEN), ph ** -0.5),
        'cmp_k_w2': nrm(ks[10], (DEPTH, CMP_HIDDEN, NSA_DH), CMP_HIDDEN ** -0.5),
        'cmp_v_pos': nrm(ks[11], (DEPTH, CMP_BLOCK, NSA_DH), 0.02),
        'cmp_v_w1': nrm(ks[12], (DEPTH, ph, CMP_HIDDEN), ph ** -0.5),
        'cmp_v_w2': nrm(ks[13], (DEPTH, CMP_HIDDEN, NSA_DH), CMP_HIDDEN ** -0.5),
        'w_branch_a': nrm(ks[14], (DEPTH, M_V, D_MODEL), M_V ** -0.5),
        'w_branch_b': nrm(ks[15], (DEPTH, N_Q, D_MODEL), N_Q ** -0.5),
        'w_out': nrm(ks[16], (DEPTH, D_MODEL, D_MODEL), D_MODEL ** -0.5),
        'norm2_g': 1.0 + nrm(ks[17], (DEPTH, D_MODEL), 0.02),
        'w_ffn_gate': nrm(ks[18], (DEPTH, D_MODEL, FFN_HIDDEN), D_MODEL ** -0.5),
        'w_ffn_up': nrm(ks[19], (DEPTH, D_MODEL, FFN_HIDDEN), D_MODEL ** -0.5),
        'w_ffn_down': nrm(ks[20], (DEPTH, FFN_HIDDEN, D_MODEL), FFN_HIDDEN ** -0.5),
        'norm_f_g': 1.0 + nrm(ks[21], (D_MODEL,), 0.02),
    }


def reference(x, norm1_g, w_in, b_in, f_bias, conv_w, conv_b, mlstm_norm_g, cmp_k_pos, cmp_k_w1, cmp_k_w2,
              cmp_v_pos, cmp_v_w1, cmp_v_w2, w_branch_a, w_branch_b, w_out, norm2_g, w_ffn_gate, w_ffn_up,
              w_ffn_down, norm_f_g):
    split_at = np.cumsum(IN_SPLITS)[:-1].tolist()
    for l in range(DEPTH):
        h = rms_norm(x, norm1_g[l])
        proj = h @ w_in[l] + b_in[l]
        (m_qk, m_v, m_o, m_i, m_f, n_q, n_kv, n_g, gate_a, gate_b) = jnp.split(proj, split_at, axis=-1)
        y_a = mlstm_branch(m_qk, m_v, m_o, m_i, m_f, f_bias[l], conv_w[l], conv_b[l], mlstm_norm_g[l])
        y_b = nsa_branch(n_q, n_g, n_kv, cmp_k_pos[l], cmp_k_w1[l], cmp_k_w2[l], cmp_v_pos[l], cmp_v_w1[l], cmp_v_w2[l])
        merged = jax.nn.sigmoid(gate_a) * (y_a @ w_branch_a[l]) + jax.nn.sigmoid(gate_b) * (y_b @ w_branch_b[l])
        x = x + merged @ w_out[l]
        h = rms_norm(x, norm2_g[l])
        x = x + (jax.nn.silu(h @ w_ffn_gate[l]) * (h @ w_ffn_up[l])) @ w_ffn_down[l]
    return rms_norm(x, norm_f_g)
```

```cpp
#include <hip/hip_runtime.h>
#include <cstdio>
#include <cstdint>
namespace pg8 {
#define PG8_LAS __attribute__((address_space(3)))
typedef unsigned short bf16_t;
typedef short bf16x8 __attribute__((ext_vector_type(8)));
typedef float f32x4 __attribute__((ext_vector_type(4)));
typedef unsigned u32x4 __attribute__((ext_vector_type(4)));
constexpr int BM = 256, BK = 64, HALF = 128, HTB = HALF * BK * 2  , STAGE_BYTES = 8 * HTB, NXCD = 8, WGM = 8;

__host__ __device__ __forceinline__ int lds_byte(int r, int c) { const int st = (r >> 4) * 2 + (c >> 5), rr = r & 15, cc = c & 31, ob = rr * 64 + cc * 2; return st * 1024 + (ob ^ (((ob >> 9) & 1) << 5)); }
__host__ __device__ __forceinline__ void stage_rc(int b, int& R, int& C) { const int st = b / 1024, sb = b % 1024, swz = sb ^ (((sb >> 9) & 1) << 5); R = (st >> 1) * 16 + swz / 64; C = (st & 1) * 32 + (swz % 64) / 2; }
__host__ __device__ __forceinline__ int perm32(int rho) { const int n = rho >> 4, i = rho & 15; return 8 * (i >> 2) + 4 * n + (i & 3); }

struct Unit { int pm, pn; };
struct Gemm { const bf16_t* A; const bf16_t* Bt; int M, N, K; };

struct StaticOrder {
    int nM, nN, nwg, G, c;
    __host__ __device__ void init(int M, int N, int G_, int c_) { nM = M / BM; nN = N / BM; nwg = nM * nN; G = G_; c = c_; }
    __host__ __device__ bool next(int i, Unit& u) const {
        const long L = (long)i * G + c; if (L >= nwg) return false;
        int wgid = (int)L; { const int q = nwg / NXCD, r = nwg % NXCD, xcd = wgid % NXCD, off = wgid / NXCD; wgid = (xcd < r ? xcd * (q + 1) : r * (q + 1) + (xcd - r) * q) + off; }
        const int nig = WGM * nN, gid = wgid / nig, fm = gid * WGM, gsz = (nM - fm) < WGM ? (nM - fm) : WGM;
        u.pm = fm + ((wgid % nig) % gsz); u.pn = (wgid % nig) / gsz; return true;
    }
    __device__ __forceinline__ void a_ready(const Unit&) const {}
    __device__ __forceinline__ void done(const Unit&) const {}
};

__device__ __forceinline__ unsigned cvt_pk_bf16(float lo, float hi) { unsigned r; asm volatile("v_cvt_pk_bf16_f32 %0, %1, %2" : "=v"(r) : "v"(lo), "v"(hi)); return r; }
typedef float f32x2 __attribute__((ext_vector_type(2)));
typedef unsigned u32x2 __attribute__((ext_vector_type(2)));
__device__ __forceinline__ float sigmoidf_(float v) { return __builtin_amdgcn_rcpf(1.0f + __builtin_amdgcn_exp2f(-1.4426950408889634f * v)); }
__device__ __forceinline__ float bf_lo(unsigned w) { return __builtin_bit_cast(float, w << 16); }
__device__ __forceinline__ float bf_hi(unsigned w) { return __builtin_bit_cast(float, w & 0xffff0000u); }
constexpr float QSCALE = 0.125f * 1.4426950408889634f;
constexpr int NKV_KIND_ELEMS = 4 * 2 * 8192 * 64;

struct EpiInProj {
    static constexpr bool PERM = true, AFTER_DRAIN = false;
    const float* bias; bf16_t* QK; bf16_t* V; bf16_t* OG; bf16_t* NQ; bf16_t* NKV; bf16_t* GA; bf16_t* GB; float* MISC;
    __device__ __forceinline__ void operator()(const f32x4 (&acc)[2][2][4][2], const Unit& u, int wr, int wc, int fr, int fq) const {
        const int pn = u.pn, row0 = u.pm * BM + wr * 64 + fr, ct = wc * 32 + 8 * fq;
        f32x4 bv[2][2];
#pragma unroll
        for (int bj = 0; bj < 2; ++bj)
#pragma unroll
            for (int n = 0; n < 2; ++n) bv[bj][n] = *(const f32x4*)(bias + pn * BM + bj * HALF + ct + 4 * n);
        int mode = 0; bf16_t* base = QK; int ldc = 1024, cbase = pn * 256;
        if (pn < 4) { base = QK; }
        else if (pn < 8) { base = V; cbase = (pn - 4) * 256; }
        else if (pn < 12) { base = OG; cbase = (pn - 8) * 256; mode = 1; }
        else if (pn < 14) { base = NQ; ldc = 512; cbase = (pn - 12) * 256; mode = 2; }
        else if (pn < 17) { mode = 3; cbase = (pn - 14) * 256; }
        else if (pn < 21) { base = GA; cbase = (pn - 17) * 256; mode = 1; }
        else if (pn < 25) { base = GB; cbase = (pn - 21) * 256; mode = 1; }
        else { mode = 4; }
#pragma unroll
        for (int ai = 0; ai < 2; ++ai)
#pragma unroll
            for (int m = 0; m < 4; ++m) {
                const int row = row0 + ai * HALF + m * 16;
#pragma unroll
                for (int bj = 0; bj < 2; ++bj) {
                    f32x4 v0 = acc[ai][bj][m][0] + bv[bj][0], v1 = acc[ai][bj][m][1] + bv[bj][1];
                    const int c = cbase + bj * HALF + ct;
                    if (mode == 4) {
                        if (bj == 0 && ct < 32) { float* p = MISC + (size_t)row * 32 + ct; *(f32x4*)p = v0; *(f32x4*)(p + 4) = v1; }
                        continue;
                    }
                    if (mode == 1) {
#pragma unroll
                        for (int i = 0; i < 4; ++i) { v0[i] = sigmoidf_(v0[i]); v1[i] = sigmoidf_(v1[i]); }
                    } else if (mode == 2) { v0 = v0 * QSCALE; v1 = v1 * QSCALE; }
                    u32x4 w; w.x = cvt_pk_bf16(v0[0], v0[1]); w.y = cvt_pk_bf16(v0[2], v0[3]); w.z = cvt_pk_bf16(v1[0], v1[1]); w.w = cvt_pk_bf16(v1[2], v1[3]);
                    bf16_t* dst;
                    if (mode == 3) { const int kind = c >> 7, g = (c >> 6) & 1, d = c & 63, b = row >> 13, t = row & 8191;
                        dst = NKV + (size_t)kind * NKV_KIND_ELEMS + ((size_t)((b * 2 + g) * 8192 + t)) * 64 + d; }
                    else dst = base + (size_t)row * ldc + c;
                    *(u32x4*)dst = w;
                }
            }
    }
};
template <bool ADD> struct EpiGateMul {
    static constexpr bool PERM = true, AFTER_DRAIN = false;
    const bf16_t* gate; const bf16_t* prev; bf16_t* out;
    __device__ __forceinline__ void operator()(const f32x4 (&acc)[2][2][4][2], const Unit& u, int wr, int wc, int fr, int fq) const {
        const int row0 = u.pm * BM + wr * 64 + fr, col0 = u.pn * BM + wc * 32 + 8 * fq;
#pragma unroll
        for (int ai = 0; ai < 2; ++ai)
#pragma unroll
            for (int m = 0; m < 4; ++m) {
                const size_t off = (size_t)(row0 + ai * HALF + m * 16) * 1024 + col0;
#pragma unroll
                for (int bj = 0; bj < 2; ++bj) {
                    const u32x4 gw = *(const u32x4*)(gate + off + bj * HALF);
                    f32x4 v0 = acc[ai][bj][m][0], v1 = acc[ai][bj][m][1];
                    v0[0] *= bf_lo(gw.x); v0[1] *= bf_hi(gw.x); v0[2] *= bf_lo(gw.y); v0[3] *= bf_hi(gw.y);
                    v1[0] *= bf_lo(gw.z); v1[1] *= bf_hi(gw.z); v1[2] *= bf_lo(gw.w); v1[3] *= bf_hi(gw.w);
                    if (ADD) { const u32x4 pw = *(const u32x4*)(prev + off + bj * HALF);
                        v0[0] += bf_lo(pw.x); v0[1] += bf_hi(pw.x); v0[2] += bf_lo(pw.y); v0[3] += bf_hi(pw.y);
                        v1[0] += bf_lo(pw.z); v1[1] += bf_hi(pw.z); v1[2] += bf_lo(pw.w); v1[3] += bf_hi(pw.w); }
                    u32x4 w; w.x = cvt_pk_bf16(v0[0], v0[1]); w.y = cvt_pk_bf16(v0[2], v0[3]); w.z = cvt_pk_bf16(v1[0], v1[1]); w.w = cvt_pk_bf16(v1[2], v1[3]);
                    *(u32x4*)(out + off + bj * HALF) = w;
                }
            }
    }
};
template <bool WRITE_BF> struct EpiResidual {
    static constexpr bool PERM = false, AFTER_DRAIN = false;
    const float* xin; float* xo; bf16_t* xb; float* ssq;
    __device__ __forceinline__ void operator()(const f32x4 (&acc)[2][2][4][2], const Unit& u, int wr, int wc, int fr, int fq) const {
        const int row0 = u.pm * BM + wr * 64 + fr, col0 = u.pn * BM + wc * 32 + 4 * fq;
#pragma unroll
        for (int ai = 0; ai < 2; ++ai)
#pragma unroll
            for (int m = 0; m < 4; ++m) {
                const int row = row0 + ai * HALF + m * 16; const size_t off = (size_t)row * 1024 + col0; float s = 0.f;
#pragma unroll
                for (int bj = 0; bj < 2; ++bj)
#pragma unroll
                    for (int n = 0; n < 2; ++n) {
                        const size_t o2 = off + bj * HALF + n * 16;
                        const f32x4 v = *(const f32x4*)(xin + o2) + acc[ai][bj][m][n];
                        *(f32x4*)(xo + o2) = v; s += (v[0] * v[0] + v[1] * v[1]) + (v[2] * v[2] + v[3] * v[3]);
                        if (WRITE_BF) { u32x2 w; w.x = cvt_pk_bf16(v[0], v[1]); w.y = cvt_pk_bf16(v[2], v[3]); *(u32x2*)(xb + o2) = w; }
                    }
                s += __shfl_xor(s, 16); s += __shfl_xor(s, 32);
                if (fq == 0) atomicAdd(ssq + row, s);
            }
    }
};
struct EpiSwiGLU {
    static constexpr bool PERM = true, AFTER_DRAIN = false;
    const float* ssq; bf16_t* act;
    __device__ __forceinline__ void operator()(const f32x4 (&acc)[2][2][4][2], const Unit& u, int wr, int wc, int fr, int fq) const {
        const int row0 = u.pm * BM + wr * 64 + fr, col0 = u.pn * HALF + wc * 32 + 8 * fq;
#pragma unroll
        for (int ai = 0; ai < 2; ++ai)
#pragma unroll
            for (int m = 0; m < 4; ++m) {
                const int row = row0 + ai * HALF + m * 16;
                const float r = __builtin_amdgcn_rsqf(ssq[row] * (1.0f / 1024.0f) + 1e-6f);
                float o[8];
#pragma unroll
                for (int n = 0; n < 2; ++n)
#pragma unroll
                    for (int i = 0; i < 4; ++i) { const float g = acc[ai][0][m][n][i] * r, up = acc[ai][1][m][n][i] * r; o[n * 4 + i] = g * sigmoidf_(g) * up; }
                u32x4 w; w.x = cvt_pk_bf16(o[0], o[1]); w.y = cvt_pk_bf16(o[2], o[3]); w.z = cvt_pk_bf16(o[4], o[5]); w.w = cvt_pk_bf16(o[6], o[7]);
                *(u32x4*)(act + (size_t)row * 2816 + col0) = w;
            }
    }
};
template <class Epi, class Sched, bool ALIGN_EPI = false, bool SP2 = false>
__device__ __forceinline__ void gemm_phase(PG8_LAS unsigned char* lds, const Gemm g, const Sched& S, const Epi& E) {
    const int tid = threadIdx.x, wid = __builtin_amdgcn_readfirstlane(tid >> 6), lane = tid & 63, wr = wid >> 2, wc = wid & 3, fr = lane & 15, fq = lane >> 4;
    const int K = g.K, nt = K / BK;
    unsigned voffA[2], voffB[2];
#pragma unroll
    for (int i = 0; i < 2; ++i) { int R, C; stage_rc(tid * 16 + i * 8192, R, C); const int Rb = Epi::PERM ? ((R & ~31) + perm32(R & 31)) : R;
        voffA[i] = (unsigned)(R * K + C) * 2u; voffB[i] = (unsigned)(Rb * K + C) * 2u; }
    const size_t kstep = (size_t)(BK * 2);
    const size_t hstep = (size_t)HALF * K * 2;
    const size_t tstep = 2 * hstep;
    const unsigned ldsw = (unsigned)wid * 1024u;
    const int aoff = lds_byte(wr * 64 + fr, fq * 8), boff = lds_byte(wc * 32 + fr, fq * 8);
#define PG8_SA(b, h) (((b) * 2 + (h)) * HTB)
#define PG8_SB(b, h) ((4 + (b) * 2 + (h)) * HTB)
#define PG8_STAGE(bufoff, gbase, voff) do { _Pragma("unroll") for (int _i = 0; _i < 2; ++_i) \
        __builtin_amdgcn_global_load_lds((const unsigned*)((const char*)(gbase) + (voff)[_i]), (PG8_LAS unsigned*)(lds + (bufoff) + ldsw + _i * 8192), 16, 0, 0); } while (0)
#define PG8_LDA(dst, b, h) do { _Pragma("unroll") for (int m = 0; m < 4; ++m) _Pragma("unroll") for (int k = 0; k < 2; ++k) dst[m][k] = *(const PG8_LAS bf16x8*)(lds + PG8_SA(b, h) + aoff + m * 2048 + k * 1024); } while (0)
#define PG8_LDB(dst, b, h) do { _Pragma("unroll") for (int n = 0; n < 2; ++n) _Pragma("unroll") for (int k = 0; k < 2; ++k) dst[n][k] = *(const PG8_LAS bf16x8*)(lds + PG8_SB(b, h) + boff + n * 2048 + k * 1024); } while (0)
#define PG8_MMA(ai, bj, At, Bt) do { __builtin_amdgcn_s_setprio(1); _Pragma("unroll") for (int m = 0; m < 4; ++m) _Pragma("unroll") for (int n = 0; n < 2; ++n) _Pragma("unroll") for (int k = 0; k < 2; ++k) \
        acc[ai][bj][m][n] = __builtin_amdgcn_mfma_f32_16x16x32_bf16(Bt[n][k], At[m][k], acc[ai][bj][m][n], 0, 0, 0); __builtin_amdgcn_s_setprio(0); } while (0)
#define PG8_WAIT_V(n) asm volatile("s_waitcnt vmcnt(" #n ")" ::: "memory")
#define PG8_WAIT_L(n) asm volatile("s_waitcnt lgkmcnt(" #n ")" ::: "memory")
#define PG8_BAR __builtin_amdgcn_s_barrier()
#define PG8_SCHED __builtin_amdgcn_sched_barrier(0)
    Unit cur, nxt; int ui = 0;
    if (!S.next(0, cur)) return;
    f32x4 acc[2][2][4][2];
#pragma unroll
    for (int a = 0; a < 2; ++a)
#pragma unroll
        for (int b = 0; b < 2; ++b)
#pragma unroll
            for (int m = 0; m < 4; ++m)
#pragma unroll
                for (int n = 0; n < 2; ++n) acc[a][b][m][n] = (f32x4){0.f, 0.f, 0.f, 0.f};
    bf16x8 At[4][2], B0[2][2], B1[2][2];
    const char* cA = (const char*)g.A + (size_t)cur.pm * tstep; const char* cB = (const char*)g.Bt + (size_t)cur.pn * tstep;
    S.a_ready(cur);
    if constexpr (SP2) {
        PG8_STAGE(PG8_SB(0, 0), cB, voffB); PG8_STAGE(PG8_SB(0, 1), cB + hstep, voffB); PG8_STAGE(PG8_SA(0, 0), cA, voffA); PG8_STAGE(PG8_SA(0, 1), cA + hstep, voffA);
        if (wr == 1) PG8_BAR;
        PG8_WAIT_V(2); PG8_BAR;
        PG8_STAGE(PG8_SB(1, 0), cB + kstep, voffB); PG8_STAGE(PG8_SA(1, 0), cA + kstep, voffA); PG8_STAGE(PG8_SB(1, 1), cB + hstep + kstep, voffB);
        PG8_WAIT_V(6); PG8_BAR;
    } else {
        PG8_STAGE(PG8_SB(0, 0), cB, voffB); PG8_STAGE(PG8_SA(0, 0), cA, voffA); PG8_STAGE(PG8_SB(0, 1), cB + hstep, voffB); PG8_STAGE(PG8_SA(0, 1), cA + hstep, voffA);
        if (wr == 1) PG8_BAR;
        PG8_WAIT_V(4); PG8_BAR;
        PG8_STAGE(PG8_SB(1, 0), cB + kstep, voffB); PG8_STAGE(PG8_SA(1, 0), cA + kstep, voffA); PG8_STAGE(PG8_SB(1, 1), cB + hstep + kstep, voffB);
        PG8_WAIT_V(6); PG8_BAR;
    }
    for (;;) {
        const bool has_next = S.next(ui + 1, nxt);
        const char* nA = has_next ? (const char*)g.A + (size_t)nxt.pm * tstep : cA; const char* nB = has_next ? (const char*)g.Bt + (size_t)nxt.pn * tstep : cB;
        for (int t = 0; t < nt; t += 2) {
            const bool last = (t == nt - 2);
            const char* a1 = cA + (size_t)(t + 1) * kstep;
            const char* a2 = last ? nA : cA + (size_t)(t + 2) * kstep; const char* b2 = last ? nB : cB + (size_t)(t + 2) * kstep;
            const char* a3 = a2 + kstep; const char* b3 = b2 + kstep;
            if (last && has_next) S.a_ready(nxt);
            if constexpr (SP2) {
            PG8_LDB(B0, 0, 0); PG8_LDB(B1, 0, 1); PG8_SCHED; PG8_LDA(At, 0, 0); PG8_STAGE(PG8_SA(1, 1), a1 + hstep, voffA);
            PG8_WAIT_V(8); PG8_WAIT_L(0); PG8_BAR; PG8_MMA(0, 0, At, B0); PG8_MMA(0, 1, At, B1); PG8_BAR; PG8_SCHED;
            PG8_LDA(At, 0, 1); PG8_STAGE(PG8_SB(0, 0), b2, voffB); PG8_STAGE(PG8_SB(0, 1), b2 + hstep, voffB); PG8_STAGE(PG8_SA(0, 0), a2, voffA);
            PG8_WAIT_V(8); PG8_WAIT_L(0); PG8_BAR; PG8_MMA(1, 0, At, B0); PG8_MMA(1, 1, At, B1); PG8_BAR; PG8_SCHED;
            PG8_LDB(B0, 1, 0); PG8_LDB(B1, 1, 1); PG8_SCHED; PG8_LDA(At, 1, 0); PG8_STAGE(PG8_SA(0, 1), a2 + hstep, voffA);
            PG8_WAIT_V(8); PG8_WAIT_L(0); PG8_BAR; PG8_MMA(0, 0, At, B0); PG8_MMA(0, 1, At, B1); PG8_BAR; PG8_SCHED;
            PG8_LDA(At, 1, 1); PG8_STAGE(PG8_SB(1, 0), b3, voffB); PG8_STAGE(PG8_SB(1, 1), b3 + hstep, voffB); PG8_STAGE(PG8_SA(1, 0), a3, voffA);
            PG8_WAIT_V(8); PG8_WAIT_L(0); PG8_BAR; PG8_MMA(1, 0, At, B0); PG8_MMA(1, 1, At, B1); PG8_BAR; PG8_SCHED;
            } else {
            PG8_LDB(B0, 0, 0); PG8_SCHED; PG8_LDA(At, 0, 0); PG8_STAGE(PG8_SA(1, 1), a1 + hstep, voffA);
            PG8_WAIT_L(8); PG8_BAR; PG8_WAIT_L(0); PG8_MMA(0, 0, At, B0); PG8_BAR; PG8_SCHED;
            PG8_LDB(B1, 0, 1); PG8_STAGE(PG8_SB(0, 0), b2, voffB);
            PG8_BAR; PG8_WAIT_L(0); PG8_MMA(0, 1, At, B1); PG8_BAR;
            PG8_LDA(At, 0, 1); PG8_STAGE(PG8_SA(0, 0), a2, voffA);
            PG8_BAR; PG8_WAIT_L(0); PG8_MMA(1, 0, At, B0); PG8_BAR; PG8_SCHED;
            PG8_STAGE(PG8_SB(0, 1), b2 + hstep, voffB);
            PG8_WAIT_V(6); PG8_BAR; PG8_MMA(1, 1, At, B1); PG8_BAR;
            PG8_LDB(B0, 1, 0); PG8_SCHED; PG8_LDA(At, 1, 0); PG8_STAGE(PG8_SA(0, 1), a2 + hstep, voffA);
            PG8_WAIT_L(8); PG8_BAR; PG8_WAIT_L(0); PG8_MMA(0, 0, At, B0); PG8_BAR; PG8_SCHED;
            PG8_LDB(B1, 1, 1); PG8_STAGE(PG8_SB(1, 0), b3, voffB);
            PG8_BAR; PG8_WAIT_L(0); PG8_MMA(0, 1, At, B1); PG8_BAR;
            PG8_LDA(At, 1, 1); PG8_STAGE(PG8_SA(1, 0), a3, voffA);
            PG8_BAR; PG8_WAIT_L(0); PG8_MMA(1, 0, At, B0); PG8_BAR; PG8_SCHED;
            PG8_STAGE(PG8_SB(1, 1), b3 + hstep, voffB);
            PG8_WAIT_V(6); PG8_BAR; PG8_MMA(1, 1, At, B1); PG8_BAR;
            }
        }
        if constexpr (ALIGN_EPI) { if (wr == 0) PG8_BAR; }
        if constexpr (!Epi::AFTER_DRAIN) { E(acc, cur, wr, wc, fr, fq); S.done(cur); }
        if (!has_next) break;
#pragma unroll
        for (int a = 0; a < 2; ++a)
#pragma unroll
            for (int b = 0; b < 2; ++b)
#pragma unroll
                for (int m = 0; m < 4; ++m)
#pragma unroll
                    for (int n = 0; n < 2; ++n) acc[a][b][m][n] = (f32x4){0.f, 0.f, 0.f, 0.f};
        cur = nxt; cA = nA; cB = nB; ++ui;
        if constexpr (ALIGN_EPI) { if (wr == 1) PG8_BAR; }
    }
    PG8_WAIT_V(0);
    if constexpr (!ALIGN_EPI) { if (wr == 0) PG8_BAR; }
    PG8_BAR;
    if constexpr (Epi::AFTER_DRAIN) { E.fused(acc, cur, wr, wc, fr, fq, lds, wid, lane); S.done(cur); }
#undef PG8_SA
#undef PG8_SB
#undef PG8_STAGE
#undef PG8_LDA
#undef PG8_LDB
#undef PG8_MMA
#undef PG8_WAIT_V
#undef PG8_WAIT_L
#undef PG8_BAR
#undef PG8_SCHED
}
}
#define GAS __attribute__((address_space(1)))
#define LAS __attribute__((address_space(3)))
typedef unsigned short bf16;
typedef unsigned v4u __attribute__((ext_vector_type(4)));
typedef float f32x4 __attribute__((ext_vector_type(4)));
typedef short bf16x8 __attribute__((ext_vector_type(8)));
typedef GAS unsigned gu32;
typedef GAS unsigned long long gu64;
#define RLX_AGENT __ATOMIC_RELAXED, __HIP_MEMORY_SCOPE_AGENT
#define LDS_WAIT() asm volatile("s_waitcnt lgkmcnt(0)" ::: "memory")
#define VM_WAIT() asm volatile("s_waitcnt vmcnt(0)" ::: "memory")
__device__ __forceinline__ unsigned long long rt() { return __builtin_amdgcn_s_memrealtime(); }
__device__ __forceinline__ unsigned f2bf(float f) { unsigned u = __builtin_bit_cast(unsigned, f); return (u + 0x7fffu + ((u >> 16) & 1u)) >> 16; }
__device__ __forceinline__ unsigned pk2(float lo, float hi) { return f2bf(lo) | (f2bf(hi) << 16); }

#define XB_TMO      128
#define XB_XCNT(j)  (256  + 64 * (j))
#define XB_XSUB(j)  (1280 + 64 * (j))
#define XB_XGEN(j)  (2304 + 64 * (j))
#define XB_TOP      3328
#define XB_TOPGEN   3392
#define XCD_BAR_WORDS 3456
#define XB_SPIN_CAP (1u << 18)

__device__ __forceinline__ unsigned xb_ld(unsigned* p)              { return __hip_atomic_load(p, __ATOMIC_RELAXED, __HIP_MEMORY_SCOPE_AGENT); }
__device__ __forceinline__ unsigned xb_add(unsigned* p, unsigned v) { return __hip_atomic_fetch_add(p, v, __ATOMIC_RELAXED, __HIP_MEMORY_SCOPE_AGENT); }
__device__ __forceinline__ unsigned xb_xcc_id() { return (unsigned)__builtin_amdgcn_s_getreg((3 << 11) | 20) & 0xFu; }
#define XB_SPIN(cond, bar) do { unsigned _sp = 0; while (cond) { __builtin_amdgcn_s_sleep(1); \
    if ((++_sp & 255u) == 0u) { if (xb_ld(&(bar)[XB_TMO])) break; if (_sp > XB_SPIN_CAP) { atomicAdd(&(bar)[XB_TMO], 1u); break; } } } } while (0)

struct XcdBarrier {
    unsigned* bar; unsigned x;
    volatile LAS unsigned* st;
};

__device__ __forceinline__ XcdBarrier xcd_barrier_post(unsigned* bar, volatile LAS unsigned* st) {
    XcdBarrier b; b.bar = bar; b.x = xb_xcc_id(); b.st = st;
    if (threadIdx.x == 0) (void)xb_add(&bar[XB_XCNT(b.x)], 1u);
    return b;
}
__device__ __forceinline__ void xcd_barrier_complete(unsigned* bar, unsigned x, unsigned& nloc, unsigned& nx) {
    const unsigned G = gridDim.x * gridDim.y * gridDim.z;
    unsigned sum, cnt, mine, sp = 0u;
    for (;;) {
        sum = 0u; cnt = 0u; mine = 0u;
#pragma unroll
        for (unsigned j = 0; j < 16; ++j) { const unsigned c = xb_ld(&bar[XB_XCNT(j)]); sum += c; cnt += (c > 0u) ? 1u : 0u; mine = (j == x) ? c : mine; }
        if (sum == G) break;
        __builtin_amdgcn_s_sleep(1);
        if ((++sp & 255u) == 0u) { if (xb_ld(&bar[XB_TMO])) break; if (sp > XB_SPIN_CAP) { atomicAdd(&bar[XB_TMO], 1u); break; } }
    }
    nloc = mine > 0u ? mine : 1u; nx = cnt > 0u ? cnt : 1u;
}

__device__ __forceinline__ void xcd_barrier(const XcdBarrier& b) {
    asm volatile("s_waitcnt vmcnt(0)" ::: "memory");
    __syncthreads();
    if (threadIdx.x == 0) {
        unsigned* bar = b.bar;
        __builtin_amdgcn_s_waitcnt(0);
        unsigned nloc = b.st[0], nx = b.st[1];
        if (nloc == 0u) { xcd_barrier_complete(bar, b.x, nloc, nx); b.st[0] = nloc; b.st[1] = nx; }
        const unsigned old = xb_add(&bar[XB_XSUB(b.x)], 1u);
        const unsigned gen = old / nloc;
        if (old + 1u == (gen + 1u) * nloc) {
            __builtin_amdgcn_fence(__ATOMIC_RELEASE, "agent");
            asm volatile("s_waitcnt vmcnt(0)" ::: "memory");
            const unsigned og = xb_add(&bar[XB_TOP], 1u);
            const unsigned tg = og / nx;
            if (og + 1u == (tg + 1u) * nx) xb_add(&bar[XB_TOPGEN], 1u);
            else XB_SPIN(xb_ld(&bar[XB_TOPGEN]) == tg, bar);
            __builtin_amdgcn_fence(__ATOMIC_ACQUIRE, "agent");
            xb_add(&bar[XB_XGEN(b.x)], 1u);
            asm volatile("s_waitcnt vmcnt(0)" ::: "memory");
        } else {
            XB_SPIN(xb_ld(&bar[XB_XGEN(b.x)]) == gen, bar);
            __builtin_amdgcn_fence(__ATOMIC_ACQUIRE, "agent");
            asm volatile("s_waitcnt vmcnt(0)" ::: "memory");
        }
    }
    __syncthreads();
}

constexpr int BATCH = 4, SEQ = 8192, DM = 1024, TOK = BATCH * SEQ;
constexpr int IN_W = 6432, NIN = 6656, FF = 2816;
constexpr float RMS_EPS = 1e-6f;
constexpr int NWAVES = 8;
constexpr size_t MiB = 1u << 20;
constexpr size_t WS_CTL = 0, CTL_ZERO_BYTES = 1 * MiB;
constexpr int CW_BAR = 4096;
constexpr size_t WS_SSQ1 = 256 * 1024, WS_SSQ2 = 384 * 1024;
constexpr size_t WS_BIASP = 1 * MiB;
constexpr size_t WS_WIN = 2 * MiB, WS_WA = 15 * MiB, WS_WB = 17 * MiB, WS_WO = 18 * MiB, WS_WGU = 20 * MiB, WS_WD = 31 * MiB;
constexpr size_t WS_MISC = 40 * MiB;
constexpr size_t WS_KCC = 44 * MiB, WS_VCC = 44 * MiB + 512 * 1024;
constexpr size_t WS_XN = 48 * MiB;
constexpr size_t WS_QM = 48 * MiB, WS_KM = 80 * MiB;
constexpr size_t WS_T1 = 48 * MiB;
constexpr size_t WS_QKR = 112 * MiB, WS_YA = 112 * MiB;
constexpr size_t WS_VM = 176 * MiB, WS_MERGED = 176 * MiB;
constexpr size_t WS_OG = 240 * MiB, WS_X1B = 240 * MiB;
constexpr size_t WS_NQ = 304 * MiB, WS_YB = 304 * MiB;
constexpr size_t WS_NKV = 336 * MiB;
constexpr size_t WS_GA = 384 * MiB, WS_GB = 448 * MiB;
constexpr size_t WS_ACT = 304 * MiB;
constexpr size_t WS_END = 512 * MiB;
constexpr int RING_BYTES = 131072, LDSCTL_OFF = RING_BYTES, MISC_OFF = LDSCTL_OFF + 320, LDS_BYTES = 147456;

__device__ __forceinline__ float bfl(unsigned w) { return __builtin_bit_cast(float, w << 16); }
__device__ __forceinline__ float bfh(unsigned w) { return __builtin_bit_cast(float, w & 0xffff0000u); }
__device__ __forceinline__ float bf2f(bf16 h) { return __builtin_bit_cast(float, (unsigned)h << 16); }
__device__ __forceinline__ float sigm(float v) { return 1.0f / (1.0f + __expf(-v)); }
__device__ __forceinline__ float wave_sum(float v) {
#pragma unroll
    for (int o = 1; o < 64; o <<= 1) v += __shfl_xor(v, o);
    return v;
}
__device__ __forceinline__ float wave_max(float v) {
#pragma unroll
    for (int o = 1; o < 64; o <<= 1) v = fmaxf(v, __shfl_xor(v, o));
    return v;
}

template <int MODE>
__device__ __forceinline__ void tr_item(const float* W, int ldw, int src_col0, int K, bf16* WT, int dst_row0, const float* rscale, LAS float* scr, int kb, int nb, int lane) {
    const int k0 = 64 * kb, n0 = 32 * nb;
#pragma unroll 8
    for (int i = 0; i < 32; ++i) { const int kk = 2 * i + (lane >> 5); float v = W[(size_t)(k0 + kk) * ldw + src_col0 + n0 + (lane & 31)]; if (rscale) v *= rscale[k0 + kk]; scr[kk * 33 + (lane & 31)] = v; }
    LDS_WAIT(); asm volatile("" ::: "memory");
    const int c = lane & 7;
#pragma unroll
    for (int j = 0; j < 4; ++j) { const int n = (lane >> 3) + 8 * j; const LAS float* s = scr + (8 * c) * 33 + n;
        v4u o; o.x = pk2(s[0 * 33], s[1 * 33]); o.y = pk2(s[2 * 33], s[3 * 33]); o.z = pk2(s[4 * 33], s[5 * 33]); o.w = pk2(s[6 * 33], s[7 * 33]);
        const int nn = n0 + n; const int drow = (MODE == 0) ? (dst_row0 + nn) : (dst_row0 + ((nn >> 7) << 8) + (nn & 127));
        *(GAS v4u*)(WT + (size_t)drow * K + k0 + 8 * c) = o; }
    LDS_WAIT(); asm volatile("" ::: "memory");
}
__device__ __forceinline__ int misc_src_col(int r) { return r < 4 ? 3072 + r : (r < 8 ? 3076 + (r - 4) : 4360 + (r - 8)); }
__device__ __forceinline__ int inproj_src_col(int n) {
    if (n < 3072) return n; if (n < 3584) return 3080 + (n - 3072); if (n < 4352) return 3592 + (n - 3584); if (n < 6400) return 4384 + (n - 4352); return misc_src_col(n - 6400);
}

struct Args { const float* in[22]; float* out; unsigned char* ws; int ph_lo, ph_hi; };

__global__ void __launch_bounds__(NWAVES * 64, 2) mk_fwd(Args args) {
    extern __shared__ __attribute__((aligned(16))) unsigned char lds[];
    LAS unsigned char* L = (LAS unsigned char*)lds;
    volatile LAS unsigned* MISCW = (volatile LAS unsigned*)(L + MISC_OFF);
    const int tid = threadIdx.x, lane = tid & 63, wave = __builtin_amdgcn_readfirstlane(tid >> 6);
    const int G = gridDim.x; const int bx = blockIdx.x; const int vcu = (G % 8 == 0) ? (bx % 8) * (G / 8) + bx / 8 : bx;
    unsigned char* ws = args.ws;
    gu32* ctl = (gu32*)(ws + WS_CTL);
    for (int u = tid; u < (LDS_BYTES - LDSCTL_OFF) / 4; u += NWAVES * 64) ((LAS unsigned*)(L + LDSCTL_OFF))[u] = 0u;
    __syncthreads();
    const int lo = args.ph_lo, hi = args.ph_hi;
    XcdBarrier bar; bar.bar = (unsigned*)(ctl + CW_BAR); bar.x = 0; bar.st = nullptr;
    if (hi - lo > 1) bar = xcd_barrier_post((unsigned*)(ctl + CW_BAR), MISCW + 8);
#define IN(k) (lo <= (k) && (k) < hi)
#define SEAM(k) do { if (IN(k) && IN((k) + 1)) xcd_barrier(bar); } while (0)

    const float* x = args.in[0];
    bf16* Wt_in = (bf16*)(ws + WS_WIN); bf16* WaT = (bf16*)(ws + WS_WA); bf16* WbT = (bf16*)(ws + WS_WB); bf16* WoT = (bf16*)(ws + WS_WO);
    bf16* WguT = (bf16*)(ws + WS_WGU); bf16* WdT = (bf16*)(ws + WS_WD);
    float* biasp = (float*)(ws + WS_BIASP); float* MISCB = (float*)(ws + WS_MISC);
    float* ssq1 = (float*)(ws + WS_SSQ1); float* ssq2 = (float*)(ws + WS_SSQ2);
    bf16* XN = (bf16*)(ws + WS_XN); bf16* QKR = (bf16*)(ws + WS_QKR); bf16* VM = (bf16*)(ws + WS_VM); bf16* OG = (bf16*)(ws + WS_OG);
    bf16* NQ = (bf16*)(ws + WS_NQ); bf16* NKV = (bf16*)(ws + WS_NKV); bf16* GA = (bf16*)(ws + WS_GA); bf16* GB = (bf16*)(ws + WS_GB);
    bf16* QM = (bf16*)(ws + WS_QM); bf16* KM = (bf16*)(ws + WS_KM);
    bf16* YA = (bf16*)(ws + WS_YA); bf16* YB = (bf16*)(ws + WS_YB); bf16* T1 = (bf16*)(ws + WS_T1); bf16* MERGED = (bf16*)(ws + WS_MERGED);
    bf16* X1B = (bf16*)(ws + WS_X1B); bf16* ACT = (bf16*)(ws + WS_ACT);
    float* OUT = args.out;
    const int gw = vcu * NWAVES + wave, NGW = G * NWAVES;
    const int gt = vcu * (NWAVES * 64) + tid, NGT = G * NWAVES * 64;

    if (IN(0)) {
        LAS float* scr = (LAS float*)(L + wave * 16384);
        const float* w_in = args.in[2]; const float* g1 = args.in[1]; const float* g2 = args.in[17];
        constexpr int I0 = 16 * 96, I1 = 16 * 16, I2 = 16 * 24, I3 = 16 * 64, I4 = 16 * 32, I5 = 8 * 32, I6 = 16 * 32, I7 = 16 * 88, I8 = 16 * 88, I9 = 44 * 32;
        constexpr int NITEMS = I0 + I1 + I2 + I3 + I4 + I5 + I6 + I7 + I8 + I9;
        for (int it = gw; it < NITEMS; it += NGW) {
            int r = it;
            if (r < I0) { tr_item<0>(w_in, IN_W, 0, 1024, Wt_in, 0, g1, scr, r / 96, r % 96, lane); continue; } r -= I0;
            if (r < I1) { tr_item<0>(w_in, IN_W, 3080, 1024, Wt_in, 3072, g1, scr, r / 16, r % 16, lane); continue; } r -= I1;
            if (r < I2) { tr_item<0>(w_in, IN_W, 3592, 1024, Wt_in, 3584, g1, scr, r / 24, r % 24, lane); continue; } r -= I2;
            if (r < I3) { tr_item<0>(w_in, IN_W, 4384, 1024, Wt_in, 4352, g1, scr, r / 64, r % 64, lane); continue; } r -= I3;
            if (r < I4) { tr_item<0>(args.in[14], 1024, 0, 1024, WaT, 0, nullptr, scr, r / 32, r % 32, lane); continue; } r -= I4;
            if (r < I5) { tr_item<0>(args.in[15], 1024, 0, 512, WbT, 0, nullptr, scr, r / 32, r % 32, lane); continue; } r -= I5;
            if (r < I6) { tr_item<0>(args.in[16], 1024, 0, 1024, WoT, 0, nullptr, scr, r / 32, r % 32, lane); continue; } r -= I6;
            if (r < I7) { tr_item<1>(args.in[18], FF, 0, 1024, WguT, 0, g2, scr, r / 88, r % 88, lane); continue; } r -= I7;
            if (r < I8) { tr_item<1>(args.in[19], FF, 0, 1024, WguT, 128, g2, scr, r / 88, r % 88, lane); continue; } r -= I8;
            tr_item<0>(args.in[20], 1024, 0, FF, WdT, 0, nullptr, scr, r / 32, r % 32, lane);
        }
        for (int idx = gt; idx < 256 * 1024; idx += NGT) { const int r = idx >> 10, k = idx & 1023;
            float v = 0.f; if (r < 32) v = w_in[(size_t)k * IN_W + misc_src_col(r)] * g1[k];
            Wt_in[(size_t)(6400 + r) * 1024 + k] = (bf16)f2bf(v); }
        for (int n = gt; n < NIN; n += NGT) biasp[n] = (n < IN_W) ? args.in[3][inproj_src_col(n)] : 0.f;
        for (int m = gw; m < TOK; m += NGW) {
            const GAS f32x4* xr = (const GAS f32x4*)(x + (size_t)m * DM) + lane;
            f32x4 v[4]; float s = 0.f;
#pragma unroll
            for (int j = 0; j < 4; ++j) { v[j] = xr[64 * j]; s += (v[j].x * v[j].x + v[j].y * v[j].y) + (v[j].z * v[j].z + v[j].w * v[j].w); }
            const float rs = 1.0f / sqrtf(wave_sum(s) * (1.f / DM) + RMS_EPS);
            GAS unsigned long long* o8 = (GAS unsigned long long*)(XN + (size_t)m * DM) + lane;
#pragma unroll
            for (int j = 0; j < 4; ++j) o8[64 * j] = (unsigned long long)pk2(v[j].x * rs, v[j].y * rs) | ((unsigned long long)pk2(v[j].z * rs, v[j].w * rs) << 32);
        }
        SEAM(0);
    }
    if (IN(1)) {
        pg8::Gemm g{XN, Wt_in, TOK, NIN, DM}; pg8::StaticOrder S; S.init(TOK, NIN, G, bx);
        pg8::EpiInProj E{biasp, QKR, VM, OG, NQ, NKV, GA, GB, MISCB};
        pg8::gemm_phase<pg8::EpiInProj, pg8::StaticOrder, true, true>(L, g, S, E);
        SEAM(1);
    }
    if (IN(2)) {
        const float* cw = args.in[5]; const float* cb = args.in[6];
        for (int item = gt; item < (TOK / 32) * 128; item += NGT) {
            const int rb = item >> 7, cg = item & 127, r0 = rb * 32, c0 = cg * 8, b = r0 >> 13, t0 = r0 & 8191;
            float w[4][8], bs[8], xm3[8], xm2[8], xm1[8];
#pragma unroll
            for (int j = 0; j < 4; ++j)
#pragma unroll
                for (int i = 0; i < 8; ++i) w[j][i] = cw[j * 1024 + c0 + i];
#pragma unroll
            for (int i = 0; i < 8; ++i) { bs[i] = cb[c0 + i]; xm3[i] = 0.f; xm2[i] = 0.f; xm1[i] = 0.f; }
            if (t0 > 0) {
                const v4u a3 = *(const GAS v4u*)(QKR + (size_t)(r0 - 3) * 1024 + c0), a2 = *(const GAS v4u*)(QKR + (size_t)(r0 - 2) * 1024 + c0), a1 = *(const GAS v4u*)(QKR + (size_t)(r0 - 1) * 1024 + c0);
                xm3[0] = bfl(a3.x); xm3[1] = bfh(a3.x); xm3[2] = bfl(a3.y); xm3[3] = bfh(a3.y); xm3[4] = bfl(a3.z); xm3[5] = bfh(a3.z); xm3[6] = bfl(a3.w); xm3[7] = bfh(a3.w);
                xm2[0] = bfl(a2.x); xm2[1] = bfh(a2.x); xm2[2] = bfl(a2.y); xm2[3] = bfh(a2.y); xm2[4] = bfl(a2.z); xm2[5] = bfh(a2.z); xm2[6] = bfl(a2.w); xm2[7] = bfh(a2.w);
                xm1[0] = bfl(a1.x); xm1[1] = bfh(a1.x); xm1[2] = bfl(a1.y); xm1[3] = bfh(a1.y); xm1[4] = bfl(a1.z); xm1[5] = bfh(a1.z); xm1[6] = bfl(a1.w); xm1[7] = bfh(a1.w);
            }
            const bool isk = c0 >= 512; const int cc = isk ? c0 - 512 : c0, h = cc >> 7, d = cc & 127;
            bf16* dst = (isk ? KM : QM) + ((size_t)((b * 4 + h) * 8192 + t0)) * 128 + d;
            const float osc = isk ? 0.08838834764831845f : 1.0f;
            for (int rr = 0; rr < 32; ++rr) {
                const v4u a0 = *(const GAS v4u*)(QKR + (size_t)(r0 + rr) * 1024 + c0);
                float xc[8] = {bfl(a0.x), bfh(a0.x), bfl(a0.y), bfh(a0.y), bfl(a0.z), bfh(a0.z), bfl(a0.w), bfh(a0.w)}; float y[8];
#pragma unroll
                for (int i = 0; i < 8; ++i) { float v = bs[i] + w[0][i] * xm3[i] + w[1][i] * xm2[i] + w[2][i] * xm1[i] + w[3][i] * xc[i]; v = v * sigm(v) * osc; y[i] = v; xm3[i] = xm2[i]; xm2[i] = xm1[i]; xm1[i] = xc[i]; }
                v4u o; o.x = pk2(y[0], y[1]); o.y = pk2(y[2], y[3]); o.z = pk2(y[4], y[5]); o.w = pk2(y[6], y[7]);
                *(GAS v4u*)(dst + (size_t)rr * 128) = o;
            }
        }
        SEAM(2);
    }
    if (IN(3)) { SEAM(3); }
    if (IN(4)) {
        { pg8::Gemm g{YA, WaT, TOK, DM, DM}; pg8::StaticOrder S; S.init(TOK, DM, G, bx);
          pg8::EpiGateMul<false> E{GA, nullptr, T1};
          pg8::gemm_phase<pg8::EpiGateMul<false>, pg8::StaticOrder, true, true>(L, g, S, E); }
        asm volatile("s_waitcnt vmcnt(0)" ::: "memory"); __syncthreads();
        { pg8::Gemm g{YB, WbT, TOK, DM, 512}; pg8::StaticOrder S; S.init(TOK, DM, G, bx);
          pg8::EpiGateMul<true> E{GB, T1, MERGED};
          pg8::gemm_phase<pg8::EpiGateMul<true>, pg8::StaticOrder, true, true>(L, g, S, E); }
        SEAM(4);
    }
    if (IN(5)) {
        pg8::Gemm g{MERGED, WoT, TOK, DM, DM}; pg8::StaticOrder S; S.init(TOK, DM, G, bx);
        pg8::EpiResidual<true> E{x, OUT, X1B, ssq1};
        pg8::gemm_phase<pg8::EpiResidual<true>, pg8::StaticOrder, true, true>(L, g, S, E);
        SEAM(5);
    }
    if (IN(6)) {
        pg8::Gemm g{X1B, WguT, TOK, 2 * FF, DM}; pg8::StaticOrder S; S.init(TOK, 2 * FF, G, bx);
        pg8::EpiSwiGLU E{ssq1, ACT};
        pg8::gemm_phase<pg8::EpiSwiGLU, pg8::StaticOrder, true, true>(L, g, S, E);
        SEAM(6);
    }
    if (IN(7)) {
        pg8::Gemm g{ACT, WdT, TOK, DM, FF}; pg8::StaticOrder S; S.init(TOK, DM, G, bx);
        pg8::EpiResidual<false> E{OUT, OUT, nullptr, ssq2};
        pg8::gemm_phase<pg8::EpiResidual<false>, pg8::StaticOrder, true, true>(L, g, S, E);
        SEAM(7);
    }
    if (IN(8)) {
        const float* gf = args.in[21];
        for (int idx = gt; idx < TOK * 256; idx += NGT) { const int row = idx >> 8, c4 = idx & 255;
            const float r = 1.0f / sqrtf(ssq2[row] * (1.f / DM) + RMS_EPS);
            GAS f32x4* p = (GAS f32x4*)(OUT + (size_t)row * DM) + c4; const f32x4 gv = *((const GAS f32x4*)gf + c4);
            f32x4 v = *p; v = v * r * gv; *p = v; }
    }
#undef IN
#undef SEAM
}

__device__ __forceinline__ float block_sum256(float v, float* red, int tid) {
    v = wave_sum(v);
    if ((tid & 63) == 0) red[tid >> 6] = v;
    __syncthreads();
    const float r = (red[0] + red[1]) + (red[2] + red[3]);
    __syncthreads();
    return r;
}
__global__ void __launch_bounds__(256) cmp_scalar(Args args) {
    __shared__ float tok[2048]; __shared__ float hid[256];
    const int tid = threadIdx.x; int id = blockIdx.x; const int c = id % 511; id /= 511; const int bg = id % 8, kind = id / 8;
    const bf16* src = (const bf16*)(args.ws + WS_NKV) + (size_t)kind * pg8::NKV_KIND_ELEMS + ((size_t)bg * 8192 + 16 * c) * 64;
    const float* pos = args.in[kind ? 11 : 8]; const float* w1 = args.in[kind ? 12 : 9]; const float* w2 = args.in[kind ? 13 : 10];
    for (int i = tid; i < 2048; i += 256) tok[i] = bf2f(src[i]) + pos[i];
    __syncthreads();
    float a = 0.f;
    for (int i = 0; i < 2048; ++i) a += tok[i] * w1[(size_t)i * 256 + tid];
    hid[tid] = a * sigm(a);
    __syncthreads();
    if (tid < 64) { float o = 0.f; for (int j = 0; j < 256; ++j) o += hid[j] * w2[j * 64 + tid];
        bf16* dst = (bf16*)(args.ws + (kind ? WS_VCC : WS_KCC)) + ((size_t)bg * 512 + c) * 64 + tid; *dst = (bf16)f2bf(o); }
}
__global__ void __launch_bounds__(256) mlstm_scalar(Args args) {
    __shared__ __attribute__((aligned(16))) bf16 qs[64 * 128]; __shared__ __attribute__((aligned(16))) bf16 ks[64 * 128]; __shared__ float gi[64], gf[64]; __shared__ float red[8];
    const int tid = threadIdx.x, bh = blockIdx.x, b = bh >> 2, h = bh & 3;
    const bf16* QM = (const bf16*)(args.ws + WS_QM) + (size_t)bh * 8192 * 128; const bf16* KM = (const bf16*)(args.ws + WS_KM) + (size_t)bh * 8192 * 128;
    const bf16* VM = (const bf16*)(args.ws + WS_VM); const bf16* OG = (const bf16*)(args.ws + WS_OG); const float* MISCB = (const float*)(args.ws + WS_MISC);
    bf16* YA = (bf16*)(args.ws + WS_YA);
    const float fb = args.in[4][h]; const float ng = args.in[7][h * 256 + tid];
    float C[128];
#pragma unroll
    for (int d = 0; d < 128; ++d) C[d] = 0.f;
    float nreg = 0.f, m = 0.f;
    for (int ch = 0; ch < 128; ++ch) {
        __syncthreads();
        for (int i = tid; i < 1024; i += 256) { ((v4u*)qs)[i] = ((const v4u*)(QM + (size_t)ch * 64 * 128))[i]; ((v4u*)ks)[i] = ((const v4u*)(KM + (size_t)ch * 64 * 128))[i]; }
        if (tid < 64) { const size_t row = (size_t)b * 8192 + ch * 64 + tid; gi[tid] = MISCB[row * 32 + h]; const float fp = MISCB[row * 32 + 4 + h] + fb;
            gf[tid] = fminf(fp, 0.f) - log1pf(__expf(-fabsf(fp))); }
        __syncthreads();
        for (int s = 0; s < 64; ++s) {
            const size_t row = (size_t)b * 8192 + ch * 64 + s;
            const float lf = gf[s], li = gi[s];
            const float mn = fmaxf(lf + m, li), fd = __expf(lf + m - mn), iw = __expf(li - mn);
            const float v = bf2f(VM[row * 1024 + h * 256 + tid]); const float vi = iw * v;
            float num = 0.f;
#pragma unroll
            for (int d8 = 0; d8 < 16; ++d8) {
                const v4u kw = ((const v4u*)(ks + s * 128))[d8], qw = ((const v4u*)(qs + s * 128))[d8];
                const float kk[8] = {bfl(kw.x), bfh(kw.x), bfl(kw.y), bfh(kw.y), bfl(kw.z), bfh(kw.z), bfl(kw.w), bfh(kw.w)};
                const float qq[8] = {bfl(qw.x), bfh(qw.x), bfl(qw.y), bfh(qw.y), bfl(qw.z), bfh(qw.z), bfl(qw.w), bfh(qw.w)};
#pragma unroll
                for (int i = 0; i < 8; ++i) { C[d8 * 8 + i] = fd * C[d8 * 8 + i] + vi * kk[i]; num += C[d8 * 8 + i] * qq[i]; }
            }
            float part = 0.f;
            if (tid < 128) { nreg = fd * nreg + iw * bf2f(ks[s * 128 + tid]); part = nreg * bf2f(qs[s * 128 + tid]); }
            const float nq = block_sum256(part, red, tid);
            const float hv = num / fmaxf(fabsf(nq), __expf(-mn));
            const float ss = block_sum256(hv * hv, red + 4, tid);
            const float y = hv * (1.0f / sqrtf(ss * (1.f / 256.f) + RMS_EPS)) * ng * bf2f(OG[row * 1024 + h * 256 + tid]);
            YA[row * 1024 + h * 256 + tid] = (bf16)f2bf(y);
            m = mn;
        }
    }
}
__device__ __forceinline__ float dot64(const float* q, const bf16* kr) {
    float s = 0.f;
#pragma unroll
    for (int d8 = 0; d8 < 8; ++d8) { const v4u w = ((const v4u*)kr)[d8]; const float* qq = q + 8 * d8;
        s += qq[0] * bfl(w.x) + qq[1] * bfh(w.x) + qq[2] * bfl(w.y) + qq[3] * bfh(w.y) + qq[4] * bfl(w.z) + qq[5] * bfh(w.z) + qq[6] * bfl(w.w) + qq[7] * bfh(w.w); }
    return s;
}
__global__ void __launch_bounds__(256) nsa_scalar(Args args) {
    __shared__ float sc[4][1024]; __shared__ float qsh[4][64]; __shared__ float imp[512]; __shared__ float sscore[128]; __shared__ int sel[16];
    const int tid = threadIdx.x, h = tid >> 6, lane = tid & 63;
    const int bgt = blockIdx.x, t = bgt & 8191, bg = bgt >> 13, b = bg >> 1, g = bg & 1;
    const size_t row = (size_t)b * 8192 + t;
    bf16* NQ = (bf16*)(args.ws + WS_NQ);
    const bf16* KCC = (const bf16*)(args.ws + WS_KCC) + (size_t)bg * 512 * 64; const bf16* VCC = (const bf16*)(args.ws + WS_VCC) + (size_t)bg * 512 * 64;
    const bf16* NKV = (const bf16*)(args.ws + WS_NKV);
    const bf16* KS = NKV + (size_t)2 * pg8::NKV_KIND_ELEMS + (size_t)bg * 8192 * 64; const bf16* VS = NKV + (size_t)3 * pg8::NKV_KIND_ELEMS + (size_t)bg * 8192 * 64;
    const bf16* KW = NKV + (size_t)4 * pg8::NKV_KIND_ELEMS + (size_t)bg * 8192 * 64; const bf16* VW = NKV + (size_t)5 * pg8::NKV_KIND_ELEMS + (size_t)bg * 8192 * 64;
    const float* MISCB = (const float*)(args.ws + WS_MISC);
    qsh[h][lane] = bf2f(NQ[row * 512 + (g * 4 + h) * 64 + lane]);
    for (int i = tid; i < 512; i += 256) imp[i] = 0.f;
    __syncthreads();
    const int nc = (t >= 31) ? ((t - 31) >> 4) + 1 : 0;
    float mx = -INFINITY;
    for (int c = lane; c < nc; c += 64) { const float s = dot64(qsh[h], KCC + (size_t)c * 64);
        sc[h][c] = s; mx = fmaxf(mx, s); }
    mx = wave_max(mx);
    float sm = 0.f;
    for (int c = lane; c < nc; c += 64) { const float e = exp2f(sc[h][c] - mx); sc[h][c] = e; sm += e; }
    sm = wave_sum(sm);
    const float inv = nc > 0 ? 1.0f / sm : 0.f;
    for (int c = lane; c < nc; c += 64) sc[h][c] *= inv;
    __syncthreads();
    float o_cmp = 0.f;
    for (int c = 0; c < nc; ++c) o_cmp += sc[h][c] * bf2f(VCC[(size_t)c * 64 + lane]);
    for (int c = tid; c < nc; c += 256) imp[c] = (sc[0][c] + sc[1][c]) + (sc[2][c] + sc[3][c]);
    __syncthreads();
    const int cur = t >> 6;
    if (tid < 128) { const int j = tid; float v = 0.f;
        { const int k0 = 4 * j - 1; if (k0 >= 0 && k0 < 511) v += imp[k0]; }
#pragma unroll
        for (int q = 0; q < 3; ++q) { const int k = 4 * j + q; if (k < 511) v += 2.f * imp[k]; }
        { const int k4 = 4 * j + 3; if (k4 < 511) v += imp[k4]; }
        const bool elig = j <= cur, forced = (j == 0) || (j == cur) || (j == cur - 1);
        sscore[j] = forced ? 1e9f : (elig ? v : -1e9f); }
    __syncthreads();
    if (tid < 128) { const float s = sscore[tid]; int rank = 0;
        for (int j = 0; j < 128; ++j) { const float o = sscore[j]; rank += (o > s || (o == s && j < tid)) ? 1 : 0; }
        if (rank < 16) sel[rank] = tid; }
    __syncthreads();
    mx = -INFINITY;
    for (int i = 0; i < 16; ++i) { const int pos = sel[i] * 64 + lane; float s = -INFINITY;
        if (pos <= t) s = dot64(qsh[h], KS + (size_t)pos * 64);
        sc[h][i * 64 + lane] = s; mx = fmaxf(mx, s); }
    mx = wave_max(mx); sm = 0.f;
    for (int i = 0; i < 16; ++i) { const float s = sc[h][i * 64 + lane]; const float e = (s == -INFINITY) ? 0.f : exp2f(s - mx); sc[h][i * 64 + lane] = e; sm += e; }
    sm = wave_sum(sm);
    __syncthreads();
    float o_slc = 0.f;
    for (int i = 0; i < 16; ++i) { const int p0 = sel[i] * 64; if (p0 > t) continue;
        for (int k = 0; k < 64; ++k) o_slc += sc[h][i * 64 + k] * bf2f(VS[(size_t)(p0 + k) * 64 + lane]); }
    o_slc /= sm;
    __syncthreads();
    mx = -INFINITY;
    for (int i = 0; i < 8; ++i) { const int pos = t - 511 + i * 64 + lane; float s = -INFINITY;
        if (pos >= 0) s = dot64(qsh[h], KW + (size_t)pos * 64);
        sc[h][i * 64 + lane] = s; mx = fmaxf(mx, s); }
    mx = wave_max(mx); sm = 0.f;
    for (int i = 0; i < 8; ++i) { const float s = sc[h][i * 64 + lane]; const float e = (s == -INFINITY) ? 0.f : exp2f(s - mx); sc[h][i * 64 + lane] = e; sm += e; }
    sm = wave_sum(sm);
    __syncthreads();
    float o_win = 0.f;
    for (int k = 0; k < 512; ++k) { const int pos = t - 511 + k; if (pos < 0) continue; o_win += sc[h][k] * bf2f(VW[(size_t)pos * 64 + lane]); }
    o_win /= sm;
    const float* gp = MISCB + row * 32 + 8 + (g * 4 + h) * 3;
    const float o = sigm(gp[0]) * o_cmp + sigm(gp[1]) * o_slc + sigm(gp[2]) * o_win;
    NQ[row * 512 + (g * 4 + h) * 64 + lane] = (bf16)f2bf(o);
}

extern "C" void kernel_launch(void* const* d_in, const int* in_sizes, int n_in, void* d_out, int out_size, void* d_ws, size_t ws_size, hipStream_t stream) {
    static int grid = 0;
    if (grid == 0) {
        if (n_in != 22 || in_sizes[0] != TOK * DM || out_size != TOK * DM || ws_size < WS_END) {
            fprintf(stderr, "kernel_launch: unexpected shapes: n_in %d in0 %d out %d ws %zu\n", n_in, n_in > 0 ? in_sizes[0] : -1, out_size, ws_size); grid = -1; return; }
        int dev = 0, cus = 0;
        if (hipGetDevice(&dev) != hipSuccess || hipDeviceGetAttribute(&cus, hipDeviceAttributeMultiprocessorCount, dev) != hipSuccess) { grid = -1; return; }
        if (hipFuncSetAttribute((const void*)mk_fwd, hipFuncAttributeMaxDynamicSharedMemorySize, LDS_BYTES) != hipSuccess) { fprintf(stderr, "kernel_launch: hipFuncSetAttribute failed\n"); grid = -1; return; }
        int per_cu = 0;
        if (hipOccupancyMaxActiveBlocksPerMultiprocessor(&per_cu, (const void*)mk_fwd, NWAVES * 64, LDS_BYTES) != hipSuccess || per_cu < 1) fprintf(stderr, "kernel_launch: occupancy query says %d\n", per_cu);
        (void)hipGetLastError();
        grid = cus;
    }
    if (grid < 0) return;
    (void)hipMemsetAsync((char*)d_ws + WS_CTL, 0, CTL_ZERO_BYTES, stream);
    Args a{};
    for (int i = 0; i < 22; ++i) a.in[i] = (const float*)d_in[i];
    a.out = (float*)d_out; a.ws = (unsigned char*)d_ws;
    auto run = [&](int lo, int hi) { a.ph_lo = lo; a.ph_hi = hi; hipLaunchKernelGGL(mk_fwd, dim3(grid), dim3(NWAVES * 64), LDS_BYTES, stream, a); };
    run(0, 1); run(1, 2); run(2, 3);
    a.ph_lo = 0; a.ph_hi = 0;
    hipLaunchKernelGGL(cmp_scalar, dim3(2 * 8 * 511), dim3(256), 0, stream, a);
    hipLaunchKernelGGL(mlstm_scalar, dim3(16), dim3(256), 0, stream, a);
    hipLaunchKernelGGL(nsa_scalar, dim3(8 * 8192), dim3(256), 0, stream, a);
    run(4, 5); run(5, 6); run(6, 7); run(7, 8); run(8, 9);
}
```

```cpp
#include <hip/hip_runtime.h>
#include <cstdio>
#include <cstdint>
namespace pg8 {
#define PG8_LAS __attribute__((address_space(3)))
typedef unsigned short bf16_t;
typedef short bf16x8 __attribute__((ext_vector_type(8)));
typedef float f32x4 __attribute__((ext_vector_type(4)));
typedef unsigned u32x4 __attribute__((ext_vector_type(4)));
constexpr int BM = 256, BK = 64, HALF = 128, HTB = HALF * BK * 2  , STAGE_BYTES = 8 * HTB, NXCD = 8, WGM = 8;

__host__ __device__ __forceinline__ int lds_byte(int r, int c) { const int st = (r >> 4) * 2 + (c >> 5), rr = r & 15, cc = c & 31, ob = rr * 64 + cc * 2; return st * 1024 + (ob ^ (((ob >> 9) & 1) << 5)); }
__host__ __device__ __forceinline__ void stage_rc(int b, int& R, int& C) { const int st = b / 1024, sb = b % 1024, swz = sb ^ (((sb >> 9) & 1) << 5); R = (st >> 1) * 16 + swz / 64; C = (st & 1) * 32 + (swz % 64) / 2; }
__host__ __device__ __forceinline__ int perm32(int rho) { const int n = rho >> 4, i = rho & 15; return 8 * (i >> 2) + 4 * n + (i & 3); }

struct Unit { int pm, pn; };
struct Gemm { const bf16_t* A; const bf16_t* Bt; int M, N, K; };

struct StaticOrder {
    int nM, nN, nwg, G, c;
    __host__ __device__ void init(int M, int N, int G_, int c_) { nM = M / BM; nN = N / BM; nwg = nM * nN; G = G_; c = c_; }
    __host__ __device__ bool next(int i, Unit& u) const {
        const long L = (long)i * G + c; if (L >= nwg) return false;
        int wgid = (int)L; { const int q = nwg / NXCD, r = nwg % NXCD, xcd = wgid % NXCD, off = wgid / NXCD; wgid = (xcd < r ? xcd * (q + 1) : r * (q + 1) + (xcd - r) * q) + off; }
        const int nig = WGM * nN, gid = wgid / nig, fm = gid * WGM, gsz = (nM - fm) < WGM ? (nM - fm) : WGM;
        u.pm = fm + ((wgid % nig) % gsz); u.pn = (wgid % nig) / gsz; return true;
    }
    __device__ __forceinline__ void a_ready(const Unit&) const {}
    __device__ __forceinline__ void done(const Unit&) const {}
};

__device__ __forceinline__ unsigned cvt_pk_bf16(float lo, float hi) { unsigned r; asm volatile("v_cvt_pk_bf16_f32 %0, %1, %2" : "=v"(r) : "v"(lo), "v"(hi)); return r; }
typedef float f32x2 __attribute__((ext_vector_type(2)));
typedef unsigned u32x2 __attribute__((ext_vector_type(2)));
__device__ __forceinline__ float sigmoidf_(float v) { return __builtin_amdgcn_rcpf(1.0f + __builtin_amdgcn_exp2f(-1.4426950408889634f * v)); }
__device__ __forceinline__ float bf_lo(unsigned w) { return __builtin_bit_cast(float, w << 16); }
__device__ __forceinline__ float bf_hi(unsigned w) { return __builtin_bit_cast(float, w & 0xffff0000u); }
constexpr float QSCALE = 0.125f * 1.4426950408889634f;
constexpr int NKV_KIND_ELEMS = 4 * 2 * 8192 * 64;

__device__ __forceinline__ float dpp_row_shr1(float x) { return __builtin_bit_cast(float, __builtin_amdgcn_update_dpp(0, __builtin_bit_cast(int, x), 0x111, 0xF, 0xF, true)); }
struct EpiInProj {
    static constexpr bool PERM = true, AFTER_DRAIN = false;
    const PG8_LAS unsigned char* lbias; bf16_t* QM; bf16_t* KM; const float* cw; const float* cb; bf16_t* RAW6; bf16_t* V; bf16_t* OG; bf16_t* NQ; bf16_t* NKV; bf16_t* GA; bf16_t* GB; float* MISC;
    __device__ __forceinline__ void operator()(const f32x4 (&acc)[2][2][4][2], const Unit& u, int wr, int wc, int fr, int fq) const {
        const int pn = u.pn, tok0 = u.pm * BM + (wr * 16 + fr) * 8, ct = wc * 32 + 8 * fq;
        f32x4 bv[2][2];
#pragma unroll
        for (int bj = 0; bj < 2; ++bj) { const u32x4 bw = *(const PG8_LAS u32x4*)(lbias + (pn * BM + bj * HALF + ct) * 2);
            bv[bj][0] = (f32x4){bf_lo(bw.x), bf_hi(bw.x), bf_lo(bw.y), bf_hi(bw.y)}; bv[bj][1] = (f32x4){bf_lo(bw.z), bf_hi(bw.z), bf_lo(bw.w), bf_hi(bw.w)}; }
        if (pn < 4) {
            const int blk = u.pm * 2 + wr;
#pragma unroll
            for (int bj = 0; bj < 2; ++bj) {
                const int cq = pn * 256 + bj * HALF + ct;
                const bool isk = cq >= 512; const int cc = cq & 511, h = cc >> 7, d = cc & 127; const float osc = isk ? 0.08838834764831845f : 1.0f;
                f32x4 w[4][2], cbv[2];
#pragma unroll
                for (int k = 0; k < 4; ++k) { w[k][0] = *(const f32x4*)(cw + k * 1024 + cq); w[k][1] = *(const f32x4*)(cw + k * 1024 + cq + 4); }
                cbv[0] = *(const f32x4*)(cb + cq); cbv[1] = *(const f32x4*)(cb + cq + 4);
                __builtin_amdgcn_s_waitcnt(0x0F70);
                f32x4 x3[2], x2[2], x1[2];
#pragma unroll
                for (int hf = 0; hf < 2; ++hf) { const f32x4 r5 = acc[1][bj][1][hf] + bv[bj][hf], r6 = acc[1][bj][2][hf] + bv[bj][hf], r7 = acc[1][bj][3][hf] + bv[bj][hf];
#pragma unroll
                    for (int i = 0; i < 4; ++i) { x3[hf][i] = dpp_row_shr1(r5[i]); x2[hf][i] = dpp_row_shr1(r6[i]); x1[hf][i] = dpp_row_shr1(r7[i]); } }
                bf16_t* dstb = (isk ? KM : QM) + ((size_t)(((tok0 >> 13) * 4 + h) * 8192 + (tok0 & 8191))) * 128 + d;
#pragma unroll
                for (int j = 0; j < 8; ++j) {
                    f32x4 xc[2], y[2];
#pragma unroll
                    for (int hf = 0; hf < 2; ++hf) { xc[hf] = acc[j >> 2][bj][j & 3][hf] + bv[bj][hf];
                        y[hf] = cbv[hf] + w[0][hf] * x3[hf] + w[1][hf] * x2[hf] + w[2][hf] * x1[hf] + w[3][hf] * xc[hf];
#pragma unroll
                        for (int i = 0; i < 4; ++i) y[hf][i] = y[hf][i] * sigmoidf_(y[hf][i]) * osc;
                        x3[hf] = x2[hf]; x2[hf] = x1[hf]; x1[hf] = xc[hf]; }
                    if (fr != 0 || j >= 3) { u32x4 o; o.x = cvt_pk_bf16(y[0][0], y[0][1]); o.y = cvt_pk_bf16(y[0][2], y[0][3]); o.z = cvt_pk_bf16(y[1][0], y[1][1]); o.w = cvt_pk_bf16(y[1][2], y[1][3]);
                        *(u32x4*)(dstb + (size_t)j * 128) = o; }
                    if ((fr == 0 && j < 3) || (fr == 15 && j >= 5)) { u32x4 o; o.x = cvt_pk_bf16(xc[0][0], xc[0][1]); o.y = cvt_pk_bf16(xc[0][2], xc[0][3]); o.z = cvt_pk_bf16(xc[1][0], xc[1][1]); o.w = cvt_pk_bf16(xc[1][2], xc[1][3]);
                        const int rr = (fr == 0) ? blk * 6 + 3 + j : (blk + 1) * 6 + (j - 5);
                        *(u32x4*)(RAW6 + (size_t)rr * 1024 + cq) = o; }
                }
            }
            return;
        }
        int mode = 0; bf16_t* base = V; int ldc = 1024, cbase = 0;
        if (pn < 8) { base = V; cbase = (pn - 4) * 256; }
        else if (pn < 12) { base = OG; cbase = (pn - 8) * 256; mode = 1; }
        else if (pn < 14) { base = NQ; ldc = 512; cbase = (pn - 12) * 256; mode = 2; }
        else if (pn < 17) { mode = 3; cbase = (pn - 14) * 256; }
        else if (pn < 21) { base = GA; cbase = (pn - 17) * 256; mode = 1; }
        else if (pn < 25) { base = GB; cbase = (pn - 21) * 256; mode = 1; }
        else { mode = 4; }
#pragma unroll
        for (int ai = 0; ai < 2; ++ai)
#pragma unroll
            for (int m = 0; m < 4; ++m) {
                const int row = tok0 + ai * 4 + m;
#pragma unroll
                for (int bj = 0; bj < 2; ++bj) {
                    f32x4 v0 = acc[ai][bj][m][0] + bv[bj][0], v1 = acc[ai][bj][m][1] + bv[bj][1];
                    const int c = cbase + bj * HALF + ct;
                    if (mode == 4) {
                        if (bj == 0 && ct < 32) { float* p = MISC + (size_t)row * 32 + ct; *(f32x4*)p = v0; *(f32x4*)(p + 4) = v1; }
                        continue;
                    }
                    if (mode == 1) {
#pragma unroll
                        for (int i = 0; i < 4; ++i) { v0[i] = sigmoidf_(v0[i]); v1[i] = sigmoidf_(v1[i]); }
                    } else if (mode == 2) { v0 = v0 * QSCALE; v1 = v1 * QSCALE; }
                    u32x4 w; w.x = cvt_pk_bf16(v0[0], v0[1]); w.y = cvt_pk_bf16(v0[2], v0[3]); w.z = cvt_pk_bf16(v1[0], v1[1]); w.w = cvt_pk_bf16(v1[2], v1[3]);
                    bf16_t* dst;
                    if (mode == 3) { const int kind = c >> 7, g = (c >> 6) & 1, d = c & 63, b = row >> 13, t = row & 8191;
                        dst = NKV + (size_t)kind * NKV_KIND_ELEMS + ((size_t)((b * 2 + g) * 8192 + t)) * 64 + d; }
                    else dst = base + (size_t)row * ldc + c;
                    *(u32x4*)dst = w;
                }
            }
    }
};
template <bool ADD> struct EpiGateMul {
    static constexpr bool PERM = true, AFTER_DRAIN = false;
    const bf16_t* gate; const bf16_t* prev; bf16_t* out;
    __device__ __forceinline__ void operator()(const f32x4 (&acc)[2][2][4][2], const Unit& u, int wr, int wc, int fr, int fq) const {
        const int row0 = u.pm * BM + wr * 64 + fr, col0 = u.pn * BM + wc * 32 + 8 * fq;
#pragma unroll
        for (int ai = 0; ai < 2; ++ai) {
            u32x4 gw[4][2], pw[ADD ? 4 : 1][2];
#pragma unroll
            for (int m = 0; m < 4; ++m)
#pragma unroll
                for (int bj = 0; bj < 2; ++bj) { const size_t off = (size_t)(row0 + ai * HALF + m * 16) * 1024 + col0 + bj * HALF;
                    gw[m][bj] = *(const u32x4*)(gate + off); if (ADD) pw[m][bj] = *(const u32x4*)(prev + off); }
#pragma unroll
            for (int m = 0; m < 4; ++m)
#pragma unroll
                for (int bj = 0; bj < 2; ++bj) { const size_t off = (size_t)(row0 + ai * HALF + m * 16) * 1024 + col0 + bj * HALF; const u32x4 g = gw[m][bj];
                    f32x4 v0 = acc[ai][bj][m][0], v1 = acc[ai][bj][m][1];
                    v0[0] *= bf_lo(g.x); v0[1] *= bf_hi(g.x); v0[2] *= bf_lo(g.y); v0[3] *= bf_hi(g.y);
                    v1[0] *= bf_lo(g.z); v1[1] *= bf_hi(g.z); v1[2] *= bf_lo(g.w); v1[3] *= bf_hi(g.w);
                    if (ADD) { const u32x4 q = pw[m][bj];
                        v0[0] += bf_lo(q.x); v0[1] += bf_hi(q.x); v0[2] += bf_lo(q.y); v0[3] += bf_hi(q.y);
                        v1[0] += bf_lo(q.z); v1[1] += bf_hi(q.z); v1[2] += bf_lo(q.w); v1[3] += bf_hi(q.w); }
                    u32x4 w; w.x = cvt_pk_bf16(v0[0], v0[1]); w.y = cvt_pk_bf16(v0[2], v0[3]); w.z = cvt_pk_bf16(v1[0], v1[1]); w.w = cvt_pk_bf16(v1[2], v1[3]);
                    *(u32x4*)(out + off) = w; }
        }
    }
};
template <bool XF32> struct EpiResidual {
    static constexpr bool PERM = false, AFTER_DRAIN = false;
    const void* xin; bf16_t* xb; float* ssq;
    __device__ __forceinline__ void operator()(const f32x4 (&acc)[2][2][4][2], const Unit& u, int wr, int wc, int fr, int fq) const {
        const int row0 = u.pm * BM + wr * 64 + fr, col0 = u.pn * BM + wc * 32 + 4 * fq;
#pragma unroll
        for (int ai = 0; ai < 2; ++ai) {
            f32x4 xv[1][4][2][2];
#pragma unroll
            for (int m = 0; m < 4; ++m)
#pragma unroll
                for (int bj = 0; bj < 2; ++bj)
#pragma unroll
                    for (int n = 0; n < 2; ++n) { const size_t o2 = (size_t)(row0 + ai * HALF + m * 16) * 1024 + col0 + bj * HALF + n * 16;
                        if (XF32) xv[0][m][bj][n] = *(const f32x4*)((const float*)xin + o2);
                        else { const u32x2 xw = *(const u32x2*)((const bf16_t*)xin + o2); xv[0][m][bj][n] = (f32x4){bf_lo(xw.x), bf_hi(xw.x), bf_lo(xw.y), bf_hi(xw.y)}; } }
#pragma unroll
            for (int m = 0; m < 4; ++m) {
                const int row = row0 + ai * HALF + m * 16; const size_t off = (size_t)row * 1024 + col0; float s = 0.f;
#pragma unroll
                for (int bj = 0; bj < 2; ++bj)
#pragma unroll
                    for (int n = 0; n < 2; ++n) {
                        const size_t o2 = off + bj * HALF + n * 16;
                        f32x4 v = xv[0][m][bj][n];
                        v = v + acc[ai][bj][m][n];
                        s += (v[0] * v[0] + v[1] * v[1]) + (v[2] * v[2] + v[3] * v[3]);
                        u32x2 w; w.x = cvt_pk_bf16(v[0], v[1]); w.y = cvt_pk_bf16(v[2], v[3]); *(u32x2*)(xb + o2) = w;
                    }
                s += __shfl_xor(s, 16); s += __shfl_xor(s, 32);
                if (fq == 0) atomicAdd(ssq + row, s);
            }
        }
    }
};
struct EpiResidNormF {
    static constexpr bool PERM = false, AFTER_DRAIN = false;
    const bf16_t* xin; const float* gf; float* out; float* slots; unsigned* cnt; PG8_LAS unsigned char* lscr;
    __device__ __forceinline__ void operator()(const f32x4 (&acc_)[2][2][4][2], const Unit& u, int wr, int wc, int fr, int fq) const {
        f32x4 (&acc)[2][2][4][2] = const_cast<f32x4 (&)[2][2][4][2]>(acc_);
        const int rl0 = wr * 64 + fr, row0 = u.pm * BM + rl0, col0 = u.pn * BM + wc * 32 + 4 * fq, tid = threadIdx.x;
        PG8_LAS float* part = (PG8_LAS float*)lscr; PG8_LAS float* rsl = part + 1024;
#pragma unroll
        for (int ai = 0; ai < 2; ++ai)
#pragma unroll
            for (int m = 0; m < 4; ++m) {
                const size_t off = (size_t)(row0 + ai * HALF + m * 16) * 1024 + col0; float s = 0.f;
#pragma unroll
                for (int bj = 0; bj < 2; ++bj)
#pragma unroll
                    for (int n = 0; n < 2; ++n) {
                        const u32x2 xw = *(const u32x2*)(xin + off + bj * HALF + n * 16);
                        f32x4 v; v[0] = bf_lo(xw.x); v[1] = bf_hi(xw.x); v[2] = bf_lo(xw.y); v[3] = bf_hi(xw.y);
                        v = v + acc[ai][bj][m][n]; acc[ai][bj][m][n] = v;
                        s += (v[0] * v[0] + v[1] * v[1]) + (v[2] * v[2] + v[3] * v[3]); }
                s += __shfl_xor(s, 16); s += __shfl_xor(s, 32);
                if (fq == 0) part[wc * 256 + rl0 + ai * HALF + m * 16] = s; }
        asm volatile("s_waitcnt lgkmcnt(0)" ::: "memory"); __builtin_amdgcn_s_barrier(); asm volatile("" ::: "memory");
        if (tid < 256) slots[((size_t)u.pm * 4 + u.pn) * 256 + tid] = (part[tid] + part[256 + tid]) + (part[512 + tid] + part[768 + tid]);
        asm volatile("s_waitcnt vmcnt(0)" ::: "memory"); __builtin_amdgcn_s_barrier(); asm volatile("" ::: "memory");
        if (tid == 0) {
            __builtin_amdgcn_fence(__ATOMIC_RELEASE, "agent"); asm volatile("s_waitcnt vmcnt(0)" ::: "memory");
            (void)__hip_atomic_fetch_add(cnt + u.pm, 1u, __ATOMIC_RELAXED, __HIP_MEMORY_SCOPE_AGENT);
            unsigned sp = 0u; while (__hip_atomic_load(cnt + u.pm, __ATOMIC_RELAXED, __HIP_MEMORY_SCOPE_AGENT) < 4u) { __builtin_amdgcn_s_sleep(1); if (++sp > (1u << 22)) break; }
            __builtin_amdgcn_fence(__ATOMIC_ACQUIRE, "agent"); asm volatile("s_waitcnt vmcnt(0)" ::: "memory"); }
        __builtin_amdgcn_s_barrier(); asm volatile("" ::: "memory");
        if (tid < 256) { const unsigned* sp4 = (const unsigned*)(slots + (size_t)u.pm * 1024 + tid);
            const float t = (__uint_as_float(__hip_atomic_load(sp4, __ATOMIC_RELAXED, __HIP_MEMORY_SCOPE_AGENT)) + __uint_as_float(__hip_atomic_load(sp4 + 256, __ATOMIC_RELAXED, __HIP_MEMORY_SCOPE_AGENT)))
                          + (__uint_as_float(__hip_atomic_load(sp4 + 512, __ATOMIC_RELAXED, __HIP_MEMORY_SCOPE_AGENT)) + __uint_as_float(__hip_atomic_load(sp4 + 768, __ATOMIC_RELAXED, __HIP_MEMORY_SCOPE_AGENT)));
            rsl[tid] = 1.0f / sqrtf(t * (1.0f / 1024.0f) + 1e-6f); }
        asm volatile("s_waitcnt lgkmcnt(0)" ::: "memory"); __builtin_amdgcn_s_barrier(); asm volatile("" ::: "memory");
        f32x4 gv[2][2];
#pragma unroll
        for (int bj = 0; bj < 2; ++bj)
#pragma unroll
            for (int n = 0; n < 2; ++n) gv[bj][n] = *(const f32x4*)(gf + col0 + bj * HALF + n * 16);
#pragma unroll
        for (int ai = 0; ai < 2; ++ai)
#pragma unroll
            for (int m = 0; m < 4; ++m) { const int rl = rl0 + ai * HALF + m * 16; const float r = rsl[rl]; const size_t off = (size_t)(u.pm * BM + rl) * 1024 + col0;
#pragma unroll
                for (int bj = 0; bj < 2; ++bj)
#pragma unroll
                    for (int n = 0; n < 2; ++n) *(f32x4*)(out + off + bj * HALF + n * 16) = acc[ai][bj][m][n] * r * gv[bj][n]; }
    }
};
struct EpiSwiGLU {
    static constexpr bool PERM = true, AFTER_DRAIN = false;
    const float* ssq; bf16_t* act;
    __device__ __forceinline__ void operator()(const f32x4 (&acc)[2][2][4][2], const Unit& u, int wr, int wc, int fr, int fq) const {
        const int row0 = u.pm * BM + wr * 64 + fr, col0 = u.pn * HALF + wc * 32 + 8 * fq;
        float sq[2][4];
#pragma unroll
        for (int ai = 0; ai < 2; ++ai)
#pragma unroll
            for (int m = 0; m < 4; ++m) sq[ai][m] = ssq[row0 + ai * HALF + m * 16];
#pragma unroll
        for (int ai = 0; ai < 2; ++ai)
#pragma unroll
            for (int m = 0; m < 4; ++m) {
                const int row = row0 + ai * HALF + m * 16;
                const float r = __builtin_amdgcn_rsqf(sq[ai][m] * (1.0f / 1024.0f) + 1e-6f);
                float o[8];
#pragma unroll
                for (int n = 0; n < 2; ++n)
#pragma unroll
                    for (int i = 0; i < 4; ++i) { const float g = acc[ai][0][m][n][i] * r, up = acc[ai][1][m][n][i] * r; o[n * 4 + i] = g * sigmoidf_(g) * up; }
                u32x4 w; w.x = cvt_pk_bf16(o[0], o[1]); w.y = cvt_pk_bf16(o[2], o[3]); w.z = cvt_pk_bf16(o[4], o[5]); w.w = cvt_pk_bf16(o[6], o[7]);
                *(u32x4*)(act + (size_t)row * 2816 + col0) = w;
            }
    }
};

struct EpiNull {
    static constexpr bool PERM = true, AFTER_DRAIN = false;
    __device__ __forceinline__ void operator()(const f32x4 (&acc)[2][2][4][2], const Unit& u, int wr, int wc, int fr, int fq) const {
#pragma unroll
        for (int ai = 0; ai < 2; ++ai)
#pragma unroll
            for (int bj = 0; bj < 2; ++bj)
#pragma unroll
                for (int m = 0; m < 4; ++m) { asm volatile("" :: "v"(acc[ai][bj][m][0]), "v"(acc[ai][bj][m][1])); }
    }
};
struct EpiSwiGLUHot {
    static constexpr bool PERM = true, AFTER_DRAIN = false;
    const float* ssq; bf16_t* act;
    __device__ __forceinline__ void operator()(const f32x4 (&acc)[2][2][4][2], const Unit& u, int wr, int wc, int fr, int fq) const {
        const int row0 = u.pm * BM + wr * 64 + fr, col0 = wc * 32 + 8 * fq;
        float sq[2][4];
#pragma unroll
        for (int ai = 0; ai < 2; ++ai)
#pragma unroll
            for (int m = 0; m < 4; ++m) sq[ai][m] = ssq[row0 + ai * HALF + m * 16];
#pragma unroll
        for (int ai = 0; ai < 2; ++ai)
#pragma unroll
            for (int m = 0; m < 4; ++m) {
                const int rowl = (blockIdx.x * 256) + wr * 64 + fr + ai * HALF + m * 16;
                const float r = __builtin_amdgcn_rsqf(sq[ai][m] * (1.0f / 1024.0f) + 1e-6f);
                float o[8];
#pragma unroll
                for (int n = 0; n < 2; ++n)
#pragma unroll
                    for (int i = 0; i < 4; ++i) { const float g = acc[ai][0][m][n][i] * r, up = acc[ai][1][m][n][i] * r; o[n * 4 + i] = g * sigmoidf_(g) * up; }
                u32x4 w; w.x = cvt_pk_bf16(o[0], o[1]); w.y = cvt_pk_bf16(o[2], o[3]); w.z = cvt_pk_bf16(o[4], o[5]); w.w = cvt_pk_bf16(o[6], o[7]);
                *(u32x4*)(act + (size_t)rowl * 128 + col0) = w;
            }
    }
};
struct EpiPlain {
    static constexpr bool PERM = true, AFTER_DRAIN = false;
    bf16_t* out; int ldc;
    __device__ __forceinline__ void operator()(const f32x4 (&acc)[2][2][4][2], const Unit& u, int wr, int wc, int fr, int fq) const {
        const int row0 = u.pm * BM + wr * 64 + fr, col0 = (u.pn & 3) * BM + wc * 32 + 8 * fq;
#pragma unroll
        for (int ai = 0; ai < 2; ++ai)
#pragma unroll
            for (int m = 0; m < 4; ++m) { bf16_t* rowp = out + (size_t)(row0 + ai * HALF + m * 16) * ldc + col0;
#pragma unroll
                for (int bj = 0; bj < 2; ++bj) { const f32x4 v0 = acc[ai][bj][m][0], v1 = acc[ai][bj][m][1];
                    u32x4 w; w.x = cvt_pk_bf16(v0[0], v0[1]); w.y = cvt_pk_bf16(v0[2], v0[3]); w.z = cvt_pk_bf16(v1[0], v1[1]); w.w = cvt_pk_bf16(v1[2], v1[3]);
                    *(u32x4*)(rowp + bj * HALF) = w; } }
    }
};
template <class Epi, class Sched, bool ALIGN_EPI = false, bool SP2 = false>
__device__ __forceinline__ void gemm_phase(PG8_LAS unsigned char* lds, const Gemm g, const Sched& S, const Epi& E) {
    const int tid = threadIdx.x, wid = __builtin_amdgcn_readfirstlane(tid >> 6), lane = tid & 63, wr = wid >> 2, wc = wid & 3, fr = lane & 15, fq = lane >> 4;
    const int K = g.K, nt = K / BK;
    unsigned voffA[2], voffB[2];
#pragma unroll
    for (int i = 0; i < 2; ++i) { int R, C; stage_rc(tid * 16 + i * 8192, R, C); const int Rb = Epi::PERM ? ((R & ~31) + perm32(R & 31)) : R;
        voffA[i] = (unsigned)(R * K + C) * 2u; voffB[i] = (unsigned)(Rb * K + C) * 2u; }
    const size_t kstep = (size_t)(BK * 2);
    const size_t hstep = (size_t)HALF * K * 2;
    const size_t tstep = 2 * hstep;
    const unsigned ldsw = (unsigned)wid * 1024u;
    const int aoff = lds_byte(wr * 64 + fr, fq * 8), boff = lds_byte(wc * 32 + fr, fq * 8);
#define PG8_SA(b, h) (((b) * 2 + (h)) * HTB)
#define PG8_SB(b, h) ((4 + (b) * 2 + (h)) * HTB)
#define PG8_STAGE(bufoff, gbase, voff) do { _Pragma("unroll") for (int _i = 0; _i < 2; ++_i) \
        __builtin_amdgcn_global_load_lds((const unsigned*)((const char*)(gbase) + (voff)[_i]), (PG8_LAS unsigned*)(lds + (bufoff) + ldsw + _i * 8192), 16, 0, 0); } while (0)
#define PG8_LDA(dst, b, h) do { _Pragma("unroll") for (int m = 0; m < 4; ++m) _Pragma("unroll") for (int k = 0; k < 2; ++k) dst[m][k] = *(const PG8_LAS bf16x8*)(lds + PG8_SA(b, h) + aoff + m * 2048 + k * 1024); } while (0)
#define PG8_LDB(dst, b, h) do { _Pragma("unroll") for (int n = 0; n < 2; ++n) _Pragma("unroll") for (int k = 0; k < 2; ++k) dst[n][k] = *(const PG8_LAS bf16x8*)(lds + PG8_SB(b, h) + boff + n * 2048 + k * 1024); } while (0)
#define PG8_MMA(ai, bj, At, Bt) do { __builtin_amdgcn_s_setprio(1); _Pragma("unroll") for (int m = 0; m < 4; ++m) _Pragma("unroll") for (int n = 0; n < 2; ++n) _Pragma("unroll") for (int k = 0; k < 2; ++k) \
        acc[ai][bj][m][n] = __builtin_amdgcn_mfma_f32_16x16x32_bf16(Bt[n][k], At[m][k], acc[ai][bj][m][n], 0, 0, 0); __builtin_amdgcn_s_setprio(0); } while (0)
#define PG8_WAIT_V(n) asm volatile("s_waitcnt vmcnt(" #n ")" ::: "memory")
#define PG8_WAIT_L(n) asm volatile("s_waitcnt lgkmcnt(" #n ")" ::: "memory")
#define PG8_BAR __builtin_amdgcn_s_barrier()
#define PG8_SCHED __builtin_amdgcn_sched_barrier(0)
    Unit cur, nxt; int ui = 0;
    if (!S.next(0, cur)) return;
    f32x4 acc[2][2][4][2];
#pragma unroll
    for (int a = 0; a < 2; ++a)
#pragma unroll
        for (int b = 0; b < 2; ++b)
#pragma unroll
            for (int m = 0; m < 4; ++m)
#pragma unroll
                for (int n = 0; n < 2; ++n) acc[a][b][m][n] = (f32x4){0.f, 0.f, 0.f, 0.f};
    bf16x8 At[4][2], B0[2][2], B1[2][2];
    const char* cA = (const char*)g.A + (size_t)cur.pm * tstep; const char* cB = (const char*)g.Bt + (size_t)cur.pn * tstep;
    S.a_ready(cur);
    if constexpr (SP2) {
        PG8_STAGE(PG8_SB(0, 0), cB, voffB); PG8_STAGE(PG8_SB(0, 1), cB + hstep, voffB); PG8_STAGE(PG8_SA(0, 0), cA, voffA); PG8_STAGE(PG8_SA(0, 1), cA + hstep, voffA);
        if (wr == 1) PG8_BAR;
        PG8_WAIT_V(2); PG8_BAR;
        PG8_STAGE(PG8_SB(1, 0), cB + kstep, voffB); PG8_STAGE(PG8_SA(1, 0), cA + kstep, voffA); PG8_STAGE(PG8_SB(1, 1), cB + hstep + kstep, voffB);
        PG8_WAIT_V(6); PG8_BAR;
    } else {
        PG8_STAGE(PG8_SB(0, 0), cB, voffB); PG8_STAGE(PG8_SA(0, 0), cA, voffA); PG8_STAGE(PG8_SB(0, 1), cB + hstep, voffB); PG8_STAGE(PG8_SA(0, 1), cA + hstep, voffA);
        if (wr == 1) PG8_BAR;
        PG8_WAIT_V(4); PG8_BAR;
        PG8_STAGE(PG8_SB(1, 0), cB + kstep, voffB); PG8_STAGE(PG8_SA(1, 0), cA + kstep, voffA); PG8_STAGE(PG8_SB(1, 1), cB + hstep + kstep, voffB);
        PG8_WAIT_V(6); PG8_BAR;
    }
    for (;;) {
        const bool has_next = S.next(ui + 1, nxt);
        const char* nA = has_next ? (const char*)g.A + (size_t)nxt.pm * tstep : cA; const char* nB = has_next ? (const char*)g.Bt + (size_t)nxt.pn * tstep : cB;
        for (int t = 0; t < nt; t += 2) {
            const bool last = (t == nt - 2);
            const char* a1 = cA + (size_t)(t + 1) * kstep;
            const char* a2 = last ? nA : cA + (size_t)(t + 2) * kstep; const char* b2 = last ? nB : cB + (size_t)(t + 2) * kstep;
            const char* a3 = a2 + kstep; const char* b3 = b2 + kstep;
            if (last && has_next) S.a_ready(nxt);
            if constexpr (SP2) {
            PG8_LDB(B0, 0, 0); PG8_LDB(B1, 0, 1); PG8_SCHED; PG8_LDA(At, 0, 0); PG8_STAGE(PG8_SA(1, 1), a1 + hstep, voffA);
            PG8_WAIT_V(8); PG8_WAIT_L(0); PG8_BAR; PG8_MMA(0, 0, At, B0); PG8_MMA(0, 1, At, B1); PG8_BAR; PG8_SCHED;
            PG8_LDA(At, 0, 1); PG8_STAGE(PG8_SB(0, 0), b2, voffB); PG8_STAGE(PG8_SB(0, 1), b2 + hstep, voffB); PG8_STAGE(PG8_SA(0, 0), a2, voffA);
            PG8_WAIT_V(8); PG8_WAIT_L(0); PG8_BAR; PG8_MMA(1, 0, At, B0); PG8_MMA(1, 1, At, B1); PG8_BAR; PG8_SCHED;
            PG8_LDB(B0, 1, 0); PG8_LDB(B1, 1, 1); PG8_SCHED; PG8_LDA(At, 1, 0); PG8_STAGE(PG8_SA(0, 1), a2 + hstep, voffA);
            PG8_WAIT_V(8); PG8_WAIT_L(0); PG8_BAR; PG8_MMA(0, 0, At, B0); PG8_MMA(0, 1, At, B1); PG8_BAR; PG8_SCHED;
            PG8_LDA(At, 1, 1); PG8_STAGE(PG8_SB(1, 0), b3, voffB); PG8_STAGE(PG8_SB(1, 1), b3 + hstep, voffB); PG8_STAGE(PG8_SA(1, 0), a3, voffA);
            PG8_WAIT_V(8); PG8_WAIT_L(0); PG8_BAR; PG8_MMA(1, 0, At, B0); PG8_MMA(1, 1, At, B1); PG8_BAR; PG8_SCHED;
            } else {
            PG8_LDB(B0, 0, 0); PG8_SCHED; PG8_LDA(At, 0, 0); PG8_STAGE(PG8_SA(1, 1), a1 + hstep, voffA);
            PG8_WAIT_L(8); PG8_BAR; PG8_WAIT_L(0); PG8_MMA(0, 0, At, B0); PG8_BAR; PG8_SCHED;
            PG8_LDB(B1, 0, 1); PG8_STAGE(PG8_SB(0, 0), b2, voffB);
            PG8_BAR; PG8_WAIT_L(0); PG8_MMA(0, 1, At, B1); PG8_BAR;
            PG8_LDA(At, 0, 1); PG8_STAGE(PG8_SA(0, 0), a2, voffA);
            PG8_BAR; PG8_WAIT_L(0); PG8_MMA(1, 0, At, B0); PG8_BAR; PG8_SCHED;
            PG8_STAGE(PG8_SB(0, 1), b2 + hstep, voffB);
            PG8_WAIT_V(6); PG8_BAR; PG8_MMA(1, 1, At, B1); PG8_BAR;
            PG8_LDB(B0, 1, 0); PG8_SCHED; PG8_LDA(At, 1, 0); PG8_STAGE(PG8_SA(0, 1), a2 + hstep, voffA);
            PG8_WAIT_L(8); PG8_BAR; PG8_WAIT_L(0); PG8_MMA(0, 0, At, B0); PG8_BAR; PG8_SCHED;
            PG8_LDB(B1, 1, 1); PG8_STAGE(PG8_SB(1, 0), b3, voffB);
            PG8_BAR; PG8_WAIT_L(0); PG8_MMA(0, 1, At, B1); PG8_BAR;
            PG8_LDA(At, 1, 1); PG8_STAGE(PG8_SA(1, 0), a3, voffA);
            PG8_BAR; PG8_WAIT_L(0); PG8_MMA(1, 0, At, B0); PG8_BAR; PG8_SCHED;
            PG8_STAGE(PG8_SB(1, 1), b3 + hstep, voffB);
            PG8_WAIT_V(6); PG8_BAR; PG8_MMA(1, 1, At, B1); PG8_BAR;
            }
        }
        if constexpr (ALIGN_EPI) { if (wr == 0) PG8_BAR; }
        if constexpr (!Epi::AFTER_DRAIN) { E(acc, cur, wr, wc, fr, fq); S.done(cur); }
        if (!has_next) break;
#pragma unroll
        for (int a = 0; a < 2; ++a)
#pragma unroll
            for (int b = 0; b < 2; ++b)
#pragma unroll
                for (int m = 0; m < 4; ++m)
#pragma unroll
                    for (int n = 0; n < 2; ++n) acc[a][b][m][n] = (f32x4){0.f, 0.f, 0.f, 0.f};
        cur = nxt; cA = nA; cB = nB; ++ui;
        if constexpr (ALIGN_EPI) { if (wr == 1) PG8_BAR; }
    }
    PG8_WAIT_V(0);
    if constexpr (!ALIGN_EPI) { if (wr == 0) PG8_BAR; }
    PG8_BAR;
    if constexpr (Epi::AFTER_DRAIN) { E.fused(acc, cur, wr, wc, fr, fq, lds, wid, lane); S.done(cur); }
#undef PG8_SA
#undef PG8_SB
#undef PG8_STAGE
#undef PG8_LDA
#undef PG8_LDB
#undef PG8_MMA
#undef PG8_WAIT_V
#undef PG8_WAIT_L
#undef PG8_BAR
#undef PG8_SCHED
}
}
#define GAS __attribute__((address_space(1)))
#define LAS __attribute__((address_space(3)))
typedef unsigned short bf16;
typedef unsigned v4u __attribute__((ext_vector_type(4)));
typedef float f32x4 __attribute__((ext_vector_type(4)));
typedef short bf16x8 __attribute__((ext_vector_type(8)));
typedef GAS unsigned gu32;
typedef GAS unsigned long long gu64;
#define RLX_AGENT __ATOMIC_RELAXED, __HIP_MEMORY_SCOPE_AGENT
#define LDS_WAIT() asm volatile("s_waitcnt lgkmcnt(0)" ::: "memory")
#define VM_WAIT() asm volatile("s_waitcnt vmcnt(0)" ::: "memory")
__device__ __forceinline__ unsigned long long rt() { return __builtin_amdgcn_s_memrealtime(); }
__device__ __forceinline__ unsigned f2bf(float f) { unsigned u = __builtin_bit_cast(unsigned, f); return (u + 0x7fffu + ((u >> 16) & 1u)) >> 16; }
__device__ __forceinline__ unsigned pk2(float lo, float hi) { return f2bf(lo) | (f2bf(hi) << 16); }

#define XB_TMO      128
#define XB_XCNT(j)  (256  + 64 * (j))
#define XB_XSUB(j)  (1280 + 64 * (j))
#define XB_XGEN(j)  (2304 + 64 * (j))
#define XB_TOP      3328
#define XB_TOPGEN   3392
#define XCD_BAR_WORDS 3456
#define XB_SPIN_CAP (1u << 18)

__device__ __forceinline__ unsigned xb_ld(unsigned* p)              { return __hip_atomic_load(p, __ATOMIC_RELAXED, __HIP_MEMORY_SCOPE_AGENT); }
__device__ __forceinline__ unsigned xb_add(unsigned* p, unsigned v) { return __hip_atomic_fetch_add(p, v, __ATOMIC_RELAXED, __HIP_MEMORY_SCOPE_AGENT); }
__device__ __forceinline__ unsigned xb_xcc_id() { return (unsigned)__builtin_amdgcn_s_getreg((3 << 11) | 20) & 0xFu; }
#define XB_SPIN(cond, bar) do { unsigned _sp = 0; while (cond) { __builtin_amdgcn_s_sleep(1); \
    if ((++_sp & 255u) == 0u) { if (xb_ld(&(bar)[XB_TMO])) break; if (_sp > XB_SPIN_CAP) { atomicAdd(&(bar)[XB_TMO], 1u); break; } } } } while (0)

struct XcdBarrier {
    unsigned* bar; unsigned x;
    volatile LAS unsigned* st;
};

__device__ __forceinline__ XcdBarrier xcd_barrier_post(unsigned* bar, volatile LAS unsigned* st) {
    XcdBarrier b; b.bar = bar; b.x = xb_xcc_id(); b.st = st;
    if (threadIdx.x == 0) (void)xb_add(&bar[XB_XCNT(b.x)], 1u);
    return b;
}
__device__ __forceinline__ void xcd_barrier_complete(unsigned* bar, unsigned x, unsigned& nloc, unsigned& nx) {
    const unsigned G = gridDim.x * gridDim.y * gridDim.z;
    unsigned sum, cnt, mine, sp = 0u;
    for (;;) {
        sum = 0u; cnt = 0u; mine = 0u;
#pragma unroll
        for (unsigned j = 0; j < 16; ++j) { const unsigned c = xb_ld(&bar[XB_XCNT(j)]); sum += c; cnt += (c > 0u) ? 1u : 0u; mine = (j == x) ? c : mine; }
        if (sum == G) break;
        __builtin_amdgcn_s_sleep(1);
        if ((++sp & 255u) == 0u) { if (xb_ld(&bar[XB_TMO])) break; if (sp > XB_SPIN_CAP) { atomicAdd(&bar[XB_TMO], 1u); break; } }
    }
    nloc = mine > 0u ? mine : 1u; nx = cnt > 0u ? cnt : 1u;
}

__device__ __forceinline__ void xcd_barrier(const XcdBarrier& b) {
    asm volatile("s_waitcnt vmcnt(0)" ::: "memory");
    __syncthreads();
    if (threadIdx.x == 0) {
        unsigned* bar = b.bar;
        __builtin_amdgcn_s_waitcnt(0);
        unsigned nloc = b.st[0], nx = b.st[1];
        if (nloc == 0u) { xcd_barrier_complete(bar, b.x, nloc, nx); b.st[0] = nloc; b.st[1] = nx; }
        const unsigned old = xb_add(&bar[XB_XSUB(b.x)], 1u);
        const unsigned gen = old / nloc;
        if (old + 1u == (gen + 1u) * nloc) {
            __builtin_amdgcn_fence(__ATOMIC_RELEASE, "agent");
            asm volatile("s_waitcnt vmcnt(0)" ::: "memory");
            const unsigned og = xb_add(&bar[XB_TOP], 1u);
            const unsigned tg = og / nx;
            if (og + 1u == (tg + 1u) * nx) xb_add(&bar[XB_TOPGEN], 1u);
            else XB_SPIN(xb_ld(&bar[XB_TOPGEN]) == tg, bar);
            __builtin_amdgcn_fence(__ATOMIC_ACQUIRE, "agent");
            xb_add(&bar[XB_XGEN(b.x)], 1u);
            asm volatile("s_waitcnt vmcnt(0)" ::: "memory");
        } else {
            XB_SPIN(xb_ld(&bar[XB_XGEN(b.x)]) == gen, bar);
            __builtin_amdgcn_fence(__ATOMIC_ACQUIRE, "agent");
            asm volatile("s_waitcnt vmcnt(0)" ::: "memory");
        }
    }
    __syncthreads();
}

constexpr int BATCH = 4, SEQ = 8192, DM = 1024, TOK = BATCH * SEQ;
constexpr int IN_W = 6432, NIN = 6656, FF = 2816;
constexpr float RMS_EPS = 1e-6f;
constexpr int NWAVES = 8;
constexpr size_t MiB = 1u << 20;
constexpr size_t WS_CTL = 0, CTL_ZERO_BYTES = 1 * MiB;
constexpr int CW_BAR = 4096;
constexpr size_t WS_SSQ1 = 256 * 1024, WS_SSQ2 = 384 * 1024;
constexpr size_t WS_KSF = 48 * MiB, WS_VSF = 56 * MiB, WS_PARK = 64 * MiB;
constexpr size_t WS_VMAX = 768 * 1024;
constexpr size_t WS_BIASP = 1 * MiB;
constexpr size_t WS_WIN = 2 * MiB, WS_WA = 15 * MiB, WS_WB = 17 * MiB, WS_WO = 18 * MiB, WS_WGU = 20 * MiB, WS_WD = 31 * MiB;
constexpr size_t WS_MISC = 40 * MiB;
constexpr size_t WS_KCC = 44 * MiB, WS_VCC = 44 * MiB + 512 * 1024;
constexpr size_t WS_XN = 48 * MiB;
constexpr size_t WS_QM = 112 * MiB, WS_KM = 144 * MiB;
constexpr size_t WS_T1 = 112 * MiB;
constexpr size_t WS_QKR = 112 * MiB, WS_YB = 80 * MiB;
constexpr size_t WS_VM = 176 * MiB, WS_YA = 176 * MiB;
constexpr size_t WS_OG = 240 * MiB, WS_X1B = 240 * MiB;
constexpr size_t WS_NQ = 304 * MiB;
constexpr size_t WS_NKV = 336 * MiB;
constexpr size_t WS_GA = 384 * MiB, WS_GB = 448 * MiB, WS_MERGED = 384 * MiB;
constexpr size_t WS_ACT = 304 * MiB;
constexpr size_t WS_END = 512 * MiB;
constexpr int RING_BYTES = 131072, LDSCTL_OFF = RING_BYTES, MISC_OFF = LDSCTL_OFF + 320, LDS_BYTES = 147456;

__device__ __forceinline__ float bfl(unsigned w) { return __builtin_bit_cast(float, w << 16); }
__device__ __forceinline__ float bfh(unsigned w) { return __builtin_bit_cast(float, w & 0xffff0000u); }
__device__ __forceinline__ float bf2f(bf16 h) { return __builtin_bit_cast(float, (unsigned)h << 16); }
__device__ __forceinline__ float sigm(float v) { return 1.0f / (1.0f + __expf(-v)); }
__device__ __forceinline__ float wave_sum(float v) {
#pragma unroll
    for (int o = 1; o < 64; o <<= 1) v += __shfl_xor(v, o);
    return v;
}
__device__ __forceinline__ float wave_max(float v) {
#pragma unroll
    for (int o = 1; o < 64; o <<= 1) v = fmaxf(v, __shfl_xor(v, o));
    return v;
}

template <int MODE>
__device__ __forceinline__ void tr_item(const float* W, int ldw, int src_col0, int K, bf16* WT, int dst_row0, const float* rscale, LAS float* scr, int kb, int nb, int lane) {
    const int k0 = 64 * kb, n0 = 32 * nb;
    {
        f32x4 v[8]; float rs[8];
#pragma unroll
        for (int i = 0; i < 8; ++i) { const int kk = 8 * i + (lane >> 3); v[i] = *(const GAS f32x4*)(W + (size_t)(k0 + kk) * ldw + src_col0 + n0 + 4 * (lane & 7)); rs[i] = rscale ? rscale[k0 + kk] : 1.0f; }
#pragma unroll
        for (int i = 0; i < 8; ++i) { const int kk = 8 * i + (lane >> 3); const f32x4 t = v[i] * rs[i]; LAS float* d = scr + kk * 33 + 4 * (lane & 7); d[0] = t.x; d[1] = t.y; d[2] = t.z; d[3] = t.w; } }
    LDS_WAIT(); asm volatile("" ::: "memory");
    const int c = lane & 7;
#pragma unroll
    for (int j = 0; j < 4; ++j) { const int n = (lane >> 3) + 8 * j; const LAS float* s = scr + (8 * c) * 33 + n;
        v4u o; o.x = pk2(s[0 * 33], s[1 * 33]); o.y = pk2(s[2 * 33], s[3 * 33]); o.z = pk2(s[4 * 33], s[5 * 33]); o.w = pk2(s[6 * 33], s[7 * 33]);
        const int nn = n0 + n;
        if (MODE == 2) { const int k8 = (k0 >> 3) + c;
            *(GAS v4u*)(WT + ((size_t)(((k8 >> 2) * (dst_row0 >> 4) + (nn >> 4)) * 64 + (k8 & 3) * 16 + (nn & 15))) * 8) = o; }
        else { const int drow = (MODE == 0) ? (dst_row0 + nn) : (dst_row0 + ((nn >> 7) << 8) + (nn & 127));
            *(GAS v4u*)(WT + (size_t)drow * K + k0 + 8 * c) = o; } }
    LDS_WAIT(); asm volatile("" ::: "memory");
}
__device__ __forceinline__ int misc_src_col(int r) { return r < 4 ? 3072 + r : (r < 8 ? 3076 + (r - 4) : 4360 + (r - 8)); }
__device__ __forceinline__ int inproj_src_col(int n) {
    if (n < 3072) return n; if (n < 3584) return 3080 + (n - 3072); if (n < 4352) return 3592 + (n - 3584); if (n < 6400) return 4384 + (n - 4352); return misc_src_col(n - 6400);
}

struct Args { const float* in[22]; float* out; unsigned char* ws; int ph_lo, ph_hi; };


__device__ __forceinline__ float block_sum256(float v, LAS float* red, int stid) {
    v = wave_sum(v);
    if ((stid & 63) == 0) red[stid >> 6] = v;
    __syncthreads();
    const float r = (red[0] + red[1]) + (red[2] + red[3]);
    __syncthreads();
    return r;
}
__device__ __forceinline__ void cmp_item(const Args& args, LAS unsigned char* Ls, int id, int stid, size_t koff, size_t voff) {
    LAS float* tok = (LAS float*)Ls; LAS float* hid = tok + 2048;
    const int c = id % 511; id /= 511; const int bg = id % 8, kind = id / 8;
    const bf16* src = (const bf16*)(args.ws + WS_NKV) + (size_t)kind * pg8::NKV_KIND_ELEMS + ((size_t)bg * 8192 + 16 * c) * 64;
    const float* pos = args.in[kind ? 11 : 8]; const float* w1 = args.in[kind ? 12 : 9]; const float* w2 = args.in[kind ? 13 : 10];
    for (int i = stid; i < 2048; i += 256) tok[i] = bf2f(src[i]) + pos[i];
    __syncthreads();
    float a = 0.f;
    for (int i = 0; i < 2048; ++i) a += tok[i] * w1[(size_t)i * 256 + stid];
    hid[stid] = a * sigm(a);
    __syncthreads();
    if (stid < 64) { float o = 0.f; for (int j = 0; j < 256; ++j) o += hid[j] * w2[j * 64 + stid];
        bf16* dst = (bf16*)(args.ws + (kind ? voff : koff)) + ((size_t)bg * 512 + c) * 64 + stid; *dst = (bf16)f2bf(o); }
    __syncthreads();
}
__device__ __forceinline__ float block_sum512(float v, LAS float* red, int tid) {
    v = wave_sum(v);
    if ((tid & 63) == 0) red[tid >> 6] = v;
    __syncthreads();
    const float r = ((red[0] + red[1]) + (red[2] + red[3])) + ((red[4] + red[5]) + (red[6] + red[7]));
    __syncthreads();
    return r;
}
__device__ __forceinline__ void mlstm_scalar_bh(const Args& args, LAS unsigned char* Ls, int bh, int tid) {
    LAS bf16* qs = (LAS bf16*)Ls; LAS bf16* ks = qs + 64 * 128; LAS float* gi = (LAS float*)(ks + 64 * 128); LAS float* gf = gi + 64; LAS float* red = gf + 64;
    const int b = bh >> 2, h = bh & 3, dv = tid >> 1, hf = tid & 1;
    const bf16* QMp = (const bf16*)(args.ws + WS_QM) + (size_t)bh * 8192 * 128; const bf16* KMp = (const bf16*)(args.ws + WS_KM) + (size_t)bh * 8192 * 128;
    const bf16* VMp = (const bf16*)(args.ws + WS_VM); const bf16* OGp = (const bf16*)(args.ws + WS_OG); const float* MISCB = (const float*)(args.ws + WS_MISC);
    bf16* YAp = (bf16*)(args.ws + WS_YA);
    const float fb = args.in[4][h]; const float ng = args.in[7][h * 256 + dv];
    float C[64];
#pragma unroll
    for (int d = 0; d < 64; ++d) C[d] = 0.f;
    float nreg = 0.f, m = 0.f;
    for (int ch = 0; ch < 128; ++ch) {
        __syncthreads();
        for (int i = tid; i < 1024; i += 512) { ((LAS v4u*)qs)[i] = ((const v4u*)(QMp + (size_t)ch * 64 * 128))[i]; ((LAS v4u*)ks)[i] = ((const v4u*)(KMp + (size_t)ch * 64 * 128))[i]; }
        if (tid < 64) { const size_t row = (size_t)b * 8192 + ch * 64 + tid; gi[tid] = MISCB[row * 32 + h]; const float fp = MISCB[row * 32 + 4 + h] + fb;
            gf[tid] = fminf(fp, 0.f) - log1pf(__expf(-fabsf(fp))); }
        __syncthreads();
        for (int s = 0; s < 64; ++s) {
            const size_t row = (size_t)b * 8192 + ch * 64 + s;
            const float lf = gf[s], li = gi[s];
            const float mn = fmaxf(lf + m, li), fd = __expf(lf + m - mn), iw = __expf(li - mn);
            const float v = bf2f(VMp[row * 1024 + h * 256 + dv]); const float vi = iw * v;
            float num = 0.f, part = 0.f;
#pragma unroll
            for (int d8 = 0; d8 < 8; ++d8) {
                const v4u kw = ((const LAS v4u*)(ks + s * 128 + hf * 64))[d8], qw = ((const LAS v4u*)(qs + s * 128 + hf * 64))[d8];
                const float kk[8] = {bfl(kw.x), bfh(kw.x), bfl(kw.y), bfh(kw.y), bfl(kw.z), bfh(kw.z), bfl(kw.w), bfh(kw.w)};
                const float qq[8] = {bfl(qw.x), bfh(qw.x), bfl(qw.y), bfh(qw.y), bfl(qw.z), bfh(qw.z), bfl(qw.w), bfh(qw.w)};
#pragma unroll
                for (int i = 0; i < 8; ++i) { C[d8 * 8 + i] = fd * C[d8 * 8 + i] + vi * kk[i]; num += C[d8 * 8 + i] * qq[i]; }
            }
            num += __shfl_xor(num, 1);
            if (tid < 128) { nreg = fd * nreg + iw * bf2f(ks[s * 128 + tid]); part = nreg * bf2f(qs[s * 128 + tid]); }
            const float nq = block_sum512(part, red, tid);
            const float hv = num / fmaxf(fabsf(nq), __expf(-mn));
            const float ss = block_sum512(hf == 0 ? hv * hv : 0.f, red + 8, tid);
            const float y = hv * (1.0f / sqrtf(ss * (1.f / 256.f) + RMS_EPS)) * ng * bf2f(OGp[row * 1024 + h * 256 + dv]);
            if (hf == 0) YAp[row * 1024 + h * 256 + dv] = (bf16)f2bf(y);
            m = mn;
        }
    }
    __syncthreads();
}
__device__ __forceinline__ float dot64(const LAS float* q, const bf16* kr) {
    float s = 0.f;
#pragma unroll
    for (int d8 = 0; d8 < 8; ++d8) { const v4u w = ((const v4u*)kr)[d8]; const LAS float* qq = q + 8 * d8;
        s += qq[0] * bfl(w.x) + qq[1] * bfh(w.x) + qq[2] * bfl(w.y) + qq[3] * bfh(w.y) + qq[4] * bfl(w.z) + qq[5] * bfh(w.z) + qq[6] * bfl(w.w) + qq[7] * bfh(w.w); }
    return s;
}
__device__ __forceinline__ void nsa_scalar_item(const Args& args, LAS unsigned char* Ls, int bgt, int stid, bool valid, bf16* outp) {
    LAS float* sc = (LAS float*)Ls;
    LAS float* qsh = sc + 4096;
    LAS float* imp = qsh + 256;
    LAS float* sscore = imp + 512;
    LAS int* sel = (LAS int*)(sscore + 128);
    const int h = stid >> 6, lane = stid & 63;
    const int t = bgt & 8191, bg = bgt >> 13, b = bg >> 1, g = bg & 1;
    const size_t row = (size_t)b * 8192 + t;
    bf16* NQp = (bf16*)(args.ws + WS_NQ);
    const bf16* KCC = (const bf16*)(args.ws + WS_KCC) + (size_t)bg * 512 * 64; const bf16* VCC = (const bf16*)(args.ws + WS_VCC) + (size_t)bg * 512 * 64;
    const bf16* NKVp = (const bf16*)(args.ws + WS_NKV);
    const bf16* KS = NKVp + (size_t)2 * pg8::NKV_KIND_ELEMS + (size_t)bg * 8192 * 64; const bf16* VS = NKVp + (size_t)3 * pg8::NKV_KIND_ELEMS + (size_t)bg * 8192 * 64;
    const bf16* KW = NKVp + (size_t)4 * pg8::NKV_KIND_ELEMS + (size_t)bg * 8192 * 64; const bf16* VW = NKVp + (size_t)5 * pg8::NKV_KIND_ELEMS + (size_t)bg * 8192 * 64;
    const float* MISCB = (const float*)(args.ws + WS_MISC);
    LAS float* sch = sc + h * 1024; LAS float* qh = qsh + h * 64;
    qh[lane] = bf2f(NQp[row * 512 + (g * 4 + h) * 64 + lane]);
    for (int i = stid; i < 512; i += 256) imp[i] = 0.f;
    __syncthreads();
    const int nc = (t >= 31) ? ((t - 31) >> 4) + 1 : 0;
    float mx = -INFINITY;
    for (int c = lane; c < nc; c += 64) { const float s = dot64(qh, KCC + (size_t)c * 64); sch[c] = s; mx = fmaxf(mx, s); }
    mx = wave_max(mx);
    float sm = 0.f;
    for (int c = lane; c < nc; c += 64) { const float e = exp2f(sch[c] - mx); sch[c] = e; sm += e; }
    sm = wave_sum(sm);
    const float inv = nc > 0 ? 1.0f / sm : 0.f;
    for (int c = lane; c < nc; c += 64) sch[c] *= inv;
    __syncthreads();
    float o_cmp = 0.f;
    for (int c = 0; c < nc; ++c) o_cmp += sch[c] * bf2f(VCC[(size_t)c * 64 + lane]);
    for (int c = stid; c < nc; c += 256) imp[c] = (sc[c] + sc[1024 + c]) + (sc[2048 + c] + sc[3072 + c]);
    __syncthreads();
    const int cur = t >> 6;
    if (stid < 128) { const int j = stid; float v = 0.f;
        { const int k0 = 4 * j - 1; if (k0 >= 0 && k0 < 511) v += imp[k0]; }
#pragma unroll
        for (int q = 0; q < 3; ++q) { const int k = 4 * j + q; if (k < 511) v += 2.f * imp[k]; }
        { const int k4 = 4 * j + 3; if (k4 < 511) v += imp[k4]; }
        const bool elig = j <= cur, forced = (j == 0) || (j == cur) || (j == cur - 1);
        sscore[j] = forced ? 1e9f : (elig ? v : -1e9f); }
    __syncthreads();
    if (stid < 128) { const float s = sscore[stid]; int rank = 0;
        for (int j = 0; j < 128; ++j) { const float o = sscore[j]; rank += (o > s || (o == s && j < stid)) ? 1 : 0; }
        if (rank < 16) sel[rank] = stid; }
    __syncthreads();
    mx = -INFINITY;
    for (int i = 0; i < 16; ++i) { const int pos = sel[i] * 64 + lane; float s = -INFINITY;
        if (pos <= t) s = dot64(qh, KS + (size_t)pos * 64);
        sch[i * 64 + lane] = s; mx = fmaxf(mx, s); }
    mx = wave_max(mx); sm = 0.f;
    for (int i = 0; i < 16; ++i) { const float s = sch[i * 64 + lane]; const float e = (s == -INFINITY) ? 0.f : exp2f(s - mx); sch[i * 64 + lane] = e; sm += e; }
    sm = wave_sum(sm);
    __syncthreads();
    float o_slc = 0.f;
    for (int i = 0; i < 16; ++i) { const int p0 = sel[i] * 64; if (p0 > t) continue;
        for (int k = 0; k < 64; ++k) o_slc += sch[i * 64 + k] * bf2f(VS[(size_t)(p0 + k) * 64 + lane]); }
    o_slc /= sm;
    __syncthreads();
    mx = -INFINITY;
    for (int i = 0; i < 8; ++i) { const int pos = t - 511 + i * 64 + lane; float s = -INFINITY;
        if (pos >= 0) s = dot64(qh, KW + (size_t)pos * 64);
        sch[i * 64 + lane] = s; mx = fmaxf(mx, s); }
    mx = wave_max(mx); sm = 0.f;
    for (int i = 0; i < 8; ++i) { const float s = sch[i * 64 + lane]; const float e = (s == -INFINITY) ? 0.f : exp2f(s - mx); sch[i * 64 + lane] = e; sm += e; }
    sm = wave_sum(sm);
    __syncthreads();
    float o_win = 0.f;
    for (int k = 0; k < 512; ++k) { const int pos = t - 511 + k; if (pos < 0) continue; o_win += sch[k] * bf2f(VW[(size_t)pos * 64 + lane]); }
    o_win /= sm;
    const float* gp = MISCB + row * 32 + 8 + (g * 4 + h) * 3;
    const float o = sigm(gp[0]) * o_cmp + sigm(gp[1]) * o_slc + sigm(gp[2]) * o_win;
    if (valid) outp[row * 512 + (g * 4 + h) * 64 + lane] = (bf16)f2bf(o);
    __syncthreads();
}

namespace nsa {
typedef float f32x4 __attribute__((ext_vector_type(4)));
typedef short bf16x8 __attribute__((ext_vector_type(8)));
typedef short s16x4 __attribute__((ext_vector_type(4)));
typedef float f32x2_t __attribute__((ext_vector_type(2)));
typedef __bf16 bf16x2_t __attribute__((ext_vector_type(2)));
typedef unsigned u32x4_t __attribute__((ext_vector_type(4)));
typedef unsigned u32x2_t __attribute__((ext_vector_type(2)));
constexpr int TB = 8192, TILE2 = 2 * TB;
constexpr int OFF_SCB = 65536;
constexpr int OFF_SELM = 132096;
constexpr int OFF_UNI = OFF_SELM + 1024;
constexpr float NEGBIG = -1e30f;
__device__ __forceinline__ unsigned cvtpk(float lo, float hi) { f32x2_t v = {lo, hi}; bf16x2_t b = __builtin_convertvector(v, bf16x2_t); return __builtin_bit_cast(unsigned, b); }
__device__ __forceinline__ s16x4 tr4(const LAS unsigned char* p) { return __builtin_bit_cast(s16x4, __builtin_amdgcn_ds_read_tr16_b64_v4i16((LAS s16x4*)p)); }
__device__ __forceinline__ float dpp_xor1(float x) { return __builtin_bit_cast(float, __builtin_amdgcn_update_dpp(0, __builtin_bit_cast(int, x), 0xB1, 0xF, 0xF, true)); }
__device__ __forceinline__ float dpp_xor2(float x) { return __builtin_bit_cast(float, __builtin_amdgcn_update_dpp(0, __builtin_bit_cast(int, x), 0x4E, 0xF, 0xF, true)); }
__device__ __forceinline__ float fq_max(float x) {
    const auto a = __builtin_amdgcn_permlane16_swap(__float_as_uint(x), __float_as_uint(x), false, false); x = fmaxf(__uint_as_float(a[0]), __uint_as_float(a[1]));
    const auto b = __builtin_amdgcn_permlane32_swap(__float_as_uint(x), __float_as_uint(x), false, false); return fmaxf(__uint_as_float(b[0]), __uint_as_float(b[1]));
}
__device__ __forceinline__ float fq_sum(float x) {
    const auto a = __builtin_amdgcn_permlane16_swap(__float_as_uint(x), __float_as_uint(x), false, false); x = __uint_as_float(a[0]) + __uint_as_float(a[1]);
    const auto b = __builtin_amdgcn_permlane32_swap(__float_as_uint(x), __float_as_uint(x), false, false); return __uint_as_float(b[0]) + __uint_as_float(b[1]);
}
__device__ __forceinline__ void glds16(const void* gsrc, unsigned lds_dst) { unsigned keep;
    asm volatile("s_mov_b32 %0, m0\n\ts_mov_b32 m0, %2\n\ts_nop 0\n\tglobal_load_lds_dwordx4 %1, off\n\ts_mov_b32 m0, %0" : "=&s"(keep) : "v"(gsrc), "s"(lds_dst) : "memory"); }
#define NSA_MFMA(a, b, c) __builtin_amdgcn_mfma_f32_16x16x32_bf16(a, b, c, 0, 0, 0)
#define EX2(x) __builtin_amdgcn_exp2f(x)
__device__ __forceinline__ int cvt_rpi(float x) { int r; asm("v_cvt_rpi_i32_f32 %0, %1" : "=v"(r) : "v"(x)); return r; }
__device__ __forceinline__ float max3f(float a, float b, float c) { float r; asm("v_max3_f32 %0, %1, %2, %3" : "=v"(r) : "v"(a), "v"(b), "v"(c)); return r; }
__device__ __forceinline__ float max16(const f32x4 (&sv)[4]) {
    float a = max3f(sv[0][0], sv[0][1], sv[0][2]), b = max3f(sv[0][3], sv[1][0], sv[1][1]), c = max3f(sv[1][2], sv[1][3], sv[2][0]), d = max3f(sv[2][1], sv[2][2], sv[2][3]);
    a = max3f(a, sv[3][0], sv[3][1]); b = max3f(b, sv[3][2], sv[3][3]); a = max3f(a, b, c); return fmaxf(a, d);
}
__device__ __forceinline__ void qk_tile_c(f32x4 (&sv)[4], const LAS unsigned char* Kt, const bf16x8 (&q)[2], int ro0, int ro1, const f32x4 cinit) {
    bf16x8 kf[8];
#pragma unroll
    for (int mt = 0; mt < 4; ++mt) { kf[2 * mt] = *(const LAS bf16x8*)(Kt + mt * 2048 + ro0); kf[2 * mt + 1] = *(const LAS bf16x8*)(Kt + mt * 2048 + ro1); }
    __builtin_amdgcn_sched_barrier(0);
#pragma unroll
    for (int mt = 0; mt < 4; ++mt) sv[mt] = NSA_MFMA(kf[2 * mt], q[0], cinit);
#pragma unroll
    for (int mt = 0; mt < 4; ++mt) sv[mt] = NSA_MFMA(kf[2 * mt + 1], q[1], sv[mt]);
}
__device__ __forceinline__ void qk_tile(f32x4 (&sv)[4], const LAS unsigned char* Kt, const bf16x8 (&q)[2], int ro0, int ro1) {
    const f32x4 Z4 = {0.f, 0.f, 0.f, 0.f};
    bf16x8 kf[8];
#pragma unroll
    for (int mt = 0; mt < 4; ++mt) { kf[2 * mt] = *(const LAS bf16x8*)(Kt + mt * 2048 + ro0); kf[2 * mt + 1] = *(const LAS bf16x8*)(Kt + mt * 2048 + ro1); }
    __builtin_amdgcn_sched_barrier(0);
#pragma unroll
    for (int mt = 0; mt < 4; ++mt) sv[mt] = NSA_MFMA(kf[2 * mt], q[0], Z4);
#pragma unroll
    for (int mt = 0; mt < 4; ++mt) sv[mt] = NSA_MFMA(kf[2 * mt + 1], q[1], sv[mt]);
}
__device__ __forceinline__ void qk_tile2(f32x4 (&sa)[4], f32x4 (&sb)[4], const LAS unsigned char* Kt, const bf16x8 (&qa)[2], const bf16x8 (&qb)[2], int ro0, int ro1, const f32x4 ca, const f32x4 cb) {
    bf16x8 kf[8];
#pragma unroll
    for (int mt = 0; mt < 4; ++mt) { kf[2 * mt] = *(const LAS bf16x8*)(Kt + mt * 2048 + ro0); kf[2 * mt + 1] = *(const LAS bf16x8*)(Kt + mt * 2048 + ro1); }
    __builtin_amdgcn_sched_barrier(0);
#pragma unroll
    for (int mt = 0; mt < 4; ++mt) { sa[mt] = NSA_MFMA(kf[2 * mt], qa[0], ca); sb[mt] = NSA_MFMA(kf[2 * mt], qb[0], cb); }
#pragma unroll
    for (int mt = 0; mt < 4; ++mt) { sa[mt] = NSA_MFMA(kf[2 * mt + 1], qa[1], sa[mt]); sb[mt] = NSA_MFMA(kf[2 * mt + 1], qb[1], sb[mt]); }
}
__device__ __forceinline__ void pack_p(bf16x8 (&pk)[2], const f32x4 (&sv)[4]) {
#pragma unroll
    for (int j = 0; j < 2; ++j) { u32x4_t pw; pw.x = cvtpk(sv[2 * j][0], sv[2 * j][1]); pw.y = cvtpk(sv[2 * j][2], sv[2 * j][3]);
        pw.z = cvtpk(sv[2 * j + 1][0], sv[2 * j + 1][1]); pw.w = cvtpk(sv[2 * j + 1][2], sv[2 * j + 1][3]); pk[j] = __builtin_bit_cast(bf16x8, pw); }
}
__device__ __forceinline__ void pv_tile(f32x4 (&o)[4], const LAS unsigned char* Vt, const int (&tro)[4], const bf16x8 (&pk)[2]) {
    s16x4 lo[8], hi[8];
#pragma unroll
    for (int dt = 0; dt < 4; ++dt)
#pragma unroll
        for (int j = 0; j < 2; ++j) { lo[dt * 2 + j] = tr4(Vt + tro[dt] + j * 4096); hi[dt * 2 + j] = tr4(Vt + tro[dt] + j * 4096 + 2048); }
    __builtin_amdgcn_sched_barrier(0);
#pragma unroll
    for (int j = 0; j < 2; ++j)
#pragma unroll
        for (int dt = 0; dt < 4; ++dt) { const s16x4 a = lo[dt * 2 + j], c = hi[dt * 2 + j];
            o[dt] = NSA_MFMA(((bf16x8){a[0], a[1], a[2], a[3], c[0], c[1], c[2], c[3]}), pk[j], o[dt]); }
}
__device__ __forceinline__ void pv_tile2(f32x4 (&o0)[4], f32x4 (&o1)[4], const LAS unsigned char* Vt, const int (&tro)[4], const bf16x8 (&pk0)[2], const bf16x8 (&pk1)[2]) {
    s16x4 lo[8], hi[8];
#pragma unroll
    for (int dt = 0; dt < 4; ++dt)
#pragma unroll
        for (int j = 0; j < 2; ++j) { lo[dt * 2 + j] = tr4(Vt + tro[dt] + j * 4096); hi[dt * 2 + j] = tr4(Vt + tro[dt] + j * 4096 + 2048); }
    __builtin_amdgcn_sched_barrier(0);
#pragma unroll
    for (int j = 0; j < 2; ++j)
#pragma unroll
        for (int dt = 0; dt < 4; ++dt) { const s16x4 a = lo[dt * 2 + j], c = hi[dt * 2 + j]; const bf16x8 vf = {a[0], a[1], a[2], a[3], c[0], c[1], c[2], c[3]};
            o0[dt] = NSA_MFMA(vf, pk0[j], o0[dt]); o1[dt] = NSA_MFMA(vf, pk1[j], o1[dt]); }
}

template <int NT>
__device__ __forceinline__ void kv_tiles(const LAS unsigned char* slot, const int (&tls)[NT], const int ib, const unsigned mbits, const int br, const int qt, const int tl_tok, const int fq,
                                         const bf16x8 (&q)[2], const int ro0, const int ro1, const int (&tro)[4], f32x4& negv, float& lB, bool& first, f32x4 (&ob)[4]) {
    f32x4 sv[NT][4];
    {   bf16x8 kf[NT][8]; f32x4 cin[NT];
#pragma unroll
        for (int t = 0; t < NT; ++t) { const LAS unsigned char* Kt = slot + tls[t] * TILE2;
#pragma unroll
            for (int mt = 0; mt < 4; ++mt) { kf[t][2 * mt] = *(const LAS bf16x8*)(Kt + mt * 2048 + ro0); kf[t][2 * mt + 1] = *(const LAS bf16x8*)(Kt + mt * 2048 + ro1); } }
#pragma unroll
        for (int t = 0; t < NT; ++t) { const bool mine = (mbits >> tls[t]) & 1u;
            cin[t][0] = mine ? negv[0] : NEGBIG; cin[t][1] = mine ? negv[1] : NEGBIG; cin[t][2] = mine ? negv[2] : NEGBIG; cin[t][3] = mine ? negv[3] : NEGBIG; }
        __builtin_amdgcn_sched_barrier(0);
#pragma unroll
        for (int t = 0; t < NT; ++t)
#pragma unroll
            for (int mt = 0; mt < 4; ++mt) sv[t][mt] = NSA_MFMA(kf[t][2 * mt], q[0], cin[t]);
#pragma unroll
        for (int t = 0; t < NT; ++t)
#pragma unroll
            for (int mt = 0; mt < 4; ++mt) sv[t][mt] = NSA_MFMA(kf[t][2 * mt + 1], q[1], sv[t][mt]);
    }
#pragma unroll
    for (int t = 0; t < NT; ++t) { const int i = ib + tls[t];
        if (br == 0 ? (i == qt) : (i == 8)) {
#pragma unroll
            for (int mt = 0; mt < 4; ++mt)
#pragma unroll
                for (int r = 0; r < 4; ++r) if (16 * mt + 4 * fq + r > tl_tok) sv[t][mt][r] = NEGBIG;
        } else if (br == 1 && i == 0) {
#pragma unroll
            for (int mt = 0; mt < 4; ++mt)
#pragma unroll
                for (int r = 0; r < 4; ++r) if (16 * mt + 4 * fq + r <= tl_tok) sv[t][mt][r] = NEGBIG;
        } }
    if (first) {
        const float trow = fq_max(max16(sv[0])); const float d = fmaxf(trow, -64.0f);
        first = false; negv = negv - d;
#pragma unroll
        for (int mt = 0; mt < 4; ++mt) sv[0][mt] = sv[0][mt] - d;
    }
    f32x4 pe[NT][4]; f32x2_t ls2 = {0.f, 0.f};
#pragma unroll
    for (int t = 0; t < NT; ++t)
#pragma unroll
        for (int mt = 0; mt < 4; ++mt) {
#pragma unroll
            for (int r = 0; r < 4; ++r) pe[t][mt][r] = EX2(sv[t][mt][r]);
            ls2 += (f32x2_t){pe[t][mt][0], pe[t][mt][1]}; ls2 += (f32x2_t){pe[t][mt][2], pe[t][mt][3]}; }
    float lsum = ls2[0] + ls2[1];
    if (__any(!(lsum < 1e30f))) {
        float tm = max16(sv[0]); if (NT == 2) tm = fmaxf(tm, max16(sv[NT - 1]));
        const float trow = fq_max(tm); const float d = fmaxf(trow, 0.f); const float alpha = EX2(-d);
        negv = negv - d; lB *= alpha;
#pragma unroll
        for (int dt = 0; dt < 4; ++dt) ob[dt] = ob[dt] * alpha;
        ls2 = (f32x2_t){0.f, 0.f};
#pragma unroll
        for (int t = 0; t < NT; ++t)
#pragma unroll
            for (int mt = 0; mt < 4; ++mt) {
#pragma unroll
                for (int r = 0; r < 4; ++r) pe[t][mt][r] = EX2(sv[t][mt][r] - d);
                ls2 += (f32x2_t){pe[t][mt][0], pe[t][mt][1]}; ls2 += (f32x2_t){pe[t][mt][2], pe[t][mt][3]}; }
        lsum = ls2[0] + ls2[1];
    }
    lB += lsum;
    bf16x8 pk[NT][2];
#pragma unroll
    for (int t = 0; t < NT; ++t) pack_p(pk[t], pe[t]);
    {   s16x4 lo[NT][8], hi[NT][8];
#pragma unroll
        for (int t = 0; t < NT; ++t) { const LAS unsigned char* Vt = slot + tls[t] * TILE2 + TB;
#pragma unroll
            for (int dt = 0; dt < 4; ++dt)
#pragma unroll
                for (int j = 0; j < 2; ++j) { lo[t][dt * 2 + j] = tr4(Vt + tro[dt] + j * 4096); hi[t][dt * 2 + j] = tr4(Vt + tro[dt] + j * 4096 + 2048); } }
        __builtin_amdgcn_sched_barrier(0);
#pragma unroll
        for (int j = 0; j < 2; ++j)
#pragma unroll
            for (int t = 0; t < NT; ++t)
#pragma unroll
                for (int dt = 0; dt < 4; ++dt) { const s16x4 a = lo[t][dt * 2 + j], c = hi[t][dt * 2 + j];
                    ob[dt] = NSA_MFMA(((bf16x8){a[0], a[1], a[2], a[3], c[0], c[1], c[2], c[3]}), pk[t][j], ob[dt]); }
    }
}

__device__ __forceinline__ void nsa_unit(const Args& args, LAS unsigned char* L, int bg, int qt, int tid, const int flags = 15, const size_t yoff = WS_YB) {
#ifdef DIAG_SEL
    unsigned dq = 0u, dsx = 0u, dp = 0u, dn = 0u;
#endif
    const unsigned ldsb = (unsigned)(uintptr_t)(unsigned char*)L;
    const int lane = tid & 63, w = __builtin_amdgcn_readfirstlane(tid >> 6), n = lane & 15, fq = lane >> 4;
    const int b = bg >> 1, g = bg & 1, t0 = qt * 64;
    const bf16* KCC = (const bf16*)(args.ws + WS_KCC) + (size_t)bg * 512 * 64; const bf16* VCC = (const bf16*)(args.ws + WS_VCC) + (size_t)bg * 512 * 64;
    const bf16* NKVp = (const bf16*)(args.ws + WS_NKV);
    const bf16* KS = NKVp + (size_t)2 * pg8::NKV_KIND_ELEMS + (size_t)bg * 8192 * 64; const bf16* VS = NKVp + (size_t)3 * pg8::NKV_KIND_ELEMS + (size_t)bg * 8192 * 64;
    const bf16* KW = NKVp + (size_t)4 * pg8::NKV_KIND_ELEMS + (size_t)bg * 8192 * 64; const bf16* VW = NKVp + (size_t)5 * pg8::NKV_KIND_ELEMS + (size_t)bg * 8192 * 64;
    const float* MISCB = (const float*)(args.ws + WS_MISC);
    const bf16* NQp = (const bf16*)(args.ws + WS_NQ);
    LAS float* scb = (LAS float*)(L + OFF_SCB); LAS unsigned* selm = (LAS unsigned*)(L + OFF_SELM); LAS unsigned* uni = (LAS unsigned*)(L + OFF_UNI);
    const f32x4 Z4 = {0.f, 0.f, 0.f, 0.f};
    int ro0 = n * 128 + ((fq ^ (n & 7)) << 4), ro1 = n * 128 + (((4 + fq) ^ (n & 7)) << 4);
    if (flags & 64) { ro0 = 0; ro1 = 16; }
    int tro[4];
    { const int q = n >> 2, p = n & 3, xr = 4 * (fq & 1) + q;
#pragma unroll
      for (int dt = 0; dt < 4; ++dt) { tro[dt] = (4 * fq + q) * 128 + ((((2 * dt) ^ (xr & 6)) | ((p >> 1) ^ (xr & 1))) << 4) + (p & 1) * 8; if (flags & 128) tro[dt] = 32 * dt; } }

    bf16x8 qf[2][2]; int tlx[2]; size_t grow[2];
#pragma unroll
    for (int s = 0; s < 2; ++s) { tlx[s] = 8 * w + 4 * s + (n >> 2); grow[s] = (size_t)b * 8192 + t0 + tlx[s];
        const bf16* qp = NQp + grow[s] * 512 + (g * 4 + (n & 3)) * 64 + 8 * fq;
        qf[s][0] = *(const GAS bf16x8*)qp; qf[s][1] = *(const GAS bf16x8*)(qp + 32); }
    float gate[2][3];
#pragma unroll
    for (int s = 0; s < 2; ++s) { const float* gp = MISCB + grow[s] * 32 + 8 + (g * 4 + (n & 3)) * 3;
#pragma unroll
        for (int k = 0; k < 3; ++k) gate[s][k] = gp[k]; }
    f32x4 ot[2][4];
#pragma unroll
    for (int s = 0; s < 2; ++s)
#pragma unroll
        for (int dt = 0; dt < 4; ++dt) ot[s][dt] = Z4;

    const int nct = (4 * qt + 3 + 63) >> 6, nstA = (nct + 1) >> 1;
    const int cmin = 4 * qt - 2;
    int cl[2];
#pragma unroll
    for (int s = 0; s < 2; ++s) { const int tt = t0 + tlx[s]; cl[s] = tt >= 31 ? ((tt - 31) >> 4) : -1; }
    float mA[2] = {NEGBIG, NEGBIG}, lA[2] = {0.f, 0.f};
    __syncthreads();
    const int dsrc = (8 * w + (lane >> 3)) * 64 + (((lane & 7) ^ ((lane >> 3) & 7)) << 3);
#define NSA_DMA(NT, slot, Kg, Vg, i0, iend, withv) do { if (flags & 256) break; _Pragma("unroll") for (int tl_ = 0; tl_ < NT; ++tl_) { const int ix_ = ((i0) + tl_ < (iend)) ? (i0) + tl_ : (iend) - 1; \
        glds16((Kg) + (ptrdiff_t)ix_ * 4096 + dsrc, (unsigned)__builtin_amdgcn_readfirstlane(ldsb + (unsigned)((slot) - L) + tl_ * TILE2 + w * 1024)); \
        if (withv) glds16((Vg) + (ptrdiff_t)ix_ * 4096 + dsrc, (unsigned)__builtin_amdgcn_readfirstlane(ldsb + (unsigned)((slot) - L) + tl_ * TILE2 + TB + w * 1024)); } } while (0)
#define NSA_SYNC() do { asm volatile("s_waitcnt vmcnt(0)" ::: "memory"); __syncthreads(); } while (0)
#ifndef NSA_AREP
#define NSA_AREP 1
#endif
#pragma unroll 1
    for (int arep = 0; arep < NSA_AREP; ++arep) {
    mA[0] = NEGBIG; mA[1] = NEGBIG; lA[0] = 0.f; lA[1] = 0.f;
#define A_SLOT(i) ((i) < 4 ? (unsigned)(i) * TILE2 : 98304u + (unsigned)((i) - 4) * TILE2)
    if (!(flags & 256)) {
#pragma unroll
        for (int i = 0; i < 8; ++i) if (i < nct) {
            glds16(KCC + (ptrdiff_t)i * 4096 + dsrc, (unsigned)__builtin_amdgcn_readfirstlane(ldsb + (i < 6 ? A_SLOT(i) : 65536u + (unsigned)(i - 6) * TB) + w * 1024));
            if (i < 6) glds16(VCC + (ptrdiff_t)i * 4096 + dsrc, (unsigned)__builtin_amdgcn_readfirstlane(ldsb + A_SLOT(i) + TB + w * 1024)); } }
    NSA_SYNC();
    __builtin_amdgcn_s_waitcnt(0x0F70);
    if (arep == 0) {
#pragma unroll
        for (int s = 0; s < 2; ++s)
#pragma unroll
            for (int k = 0; k < 3; ++k) gate[s][k] = 1.0f / (1.0f + __expf(-gate[s][k])); }
#pragma unroll 1
    for (int i = 0; i < nct; ++i) { const LAS unsigned char* Kt1 = L + (i < 6 ? A_SLOT(i) : 65536u + (unsigned)(i - 6) * TB);
            const bool bnd = 64 * i + 63 > cmin;
            f32x4 sv2[2][4]; qk_tile2(sv2[0], sv2[1], Kt1, qf[0], qf[1], ro0, ro1, Z4, Z4);
#pragma unroll
            for (int s = 0; s < 2; ++s) { f32x4 (&sv)[4] = sv2[s];
                if (bnd) { asm volatile("" ::: "memory");
#pragma unroll
                    for (int mt = 0; mt < 4; ++mt)
#pragma unroll
                        for (int r = 0; r < 4; ++r) if (64 * i + 16 * mt + 4 * fq + r > cl[s]) sv[mt][r] = NEGBIG; }
                float tm = fmaxf(fmaxf(sv[0][0], sv[0][1]), fmaxf(sv[0][2], sv[0][3]));
#pragma unroll
                for (int mt = 1; mt < 4; ++mt) tm = fmaxf(tm, fmaxf(fmaxf(sv[mt][0], sv[mt][1]), fmaxf(sv[mt][2], sv[mt][3])));
                const float mn = fmaxf(mA[s], tm); const float me = mn > -1e29f ? mn : 1e30f; float ls = lA[s] * EX2(mA[s] - mn);
#pragma unroll
                for (int mt = 0; mt < 4; ++mt)
#pragma unroll
                    for (int r = 0; r < 4; ++r) ls += EX2(sv[mt][r] - me);
                mA[s] = mn; lA[s] = ls; } }
    __syncthreads();
    float invA[2], cA[2];
#pragma unroll
    for (int s = 0; s < 2; ++s) { const float M = fq_max(mA[s]); const float l = fq_sum(lA[s] * EX2(mA[s] - M));
        mA[s] = M > -1e29f ? M : 1e30f; invA[s] = l > 0.f ? 1.0f / l : 0.f;
        cA[s] = l > 0.f ? -M - __builtin_amdgcn_logf(l) : NEGBIG; }
    {
        f32x4 oc[2][4];
#pragma unroll
        for (int s = 0; s < 2; ++s)
#pragma unroll
            for (int dt = 0; dt < 4; ++dt) oc[s][dt] = Z4;
        float y3prev[2] = {0.f, 0.f};
#pragma unroll 1
        for (int i = 0; i < nct; ++i) {
            {   if (i == 6) NSA_SYNC();
                const bool bnd = 64 * i + 63 > cmin; const LAS unsigned char* Kt = L + (i < 6 ? A_SLOT(i) : (unsigned)(i - 6) * TILE2); const LAS unsigned char* Vt = Kt + TB;
                bf16x8 pk[2][2];
                f32x4 sv2[2][4]; { const f32x4 ca = {cA[0], cA[0], cA[0], cA[0]}, cb = {cA[1], cA[1], cA[1], cA[1]}; qk_tile2(sv2[0], sv2[1], Kt, qf[0], qf[1], ro0, ro1, ca, cb); }
#pragma unroll
                for (int s = 0; s < 2; ++s) { f32x4 (&sv)[4] = sv2[s];
                    if (bnd) { asm volatile("" ::: "memory");
#pragma unroll
                        for (int mt = 0; mt < 4; ++mt)
#pragma unroll
                            for (int r = 0; r < 4; ++r) if (64 * i + 16 * mt + 4 * fq + r > cl[s]) sv[mt][r] = NEGBIG; }
                    float a[4], c3[4];
#pragma unroll
                    for (int mt = 0; mt < 4; ++mt) {
#pragma unroll
                        for (int r = 0; r < 4; ++r) sv[mt][r] = EX2(sv[mt][r]);
                        float aa = 2.f * (sv[mt][0] + sv[mt][1] + sv[mt][2]) + sv[mt][3], cc = sv[mt][3];
                        aa += dpp_xor1(aa); aa += dpp_xor2(aa); cc += dpp_xor1(cc); cc += dpp_xor2(cc);
                        a[mt] = aa; c3[mt] = cc; }
                    float y[4];
#pragma unroll
                    for (int mt = 0; mt < 4; ++mt) y[mt] = __shfl(c3[mt], (lane + 48) & 63);
                    if ((n & 3) == 0) {
#pragma unroll
                        for (int mt = 0; mt < 4; ++mt) { const float prev = (fq > 0) ? y[mt] : (mt > 0 ? y[mt > 0 ? mt - 1 : 0] : y3prev[s]);
                            scb[tlx[s] * 128 + 16 * i + 4 * mt + fq] = a[mt] + prev; } }
                    y3prev[s] = y[3];
                    pack_p(pk[s], sv); }
                pv_tile2(oc[0], oc[1], Vt, tro, pk[0], pk[1]); }
            if (i == 1 && nct > 6) { __syncthreads();
                if (!(flags & 256)) for (int i2 = 6; i2 < nct; ++i2) {
                    glds16(KCC + (ptrdiff_t)i2 * 4096 + dsrc, (unsigned)__builtin_amdgcn_readfirstlane(ldsb + (unsigned)(i2 - 6) * TILE2 + w * 1024));
                    glds16(VCC + (ptrdiff_t)i2 * 4096 + dsrc, (unsigned)__builtin_amdgcn_readfirstlane(ldsb + (unsigned)(i2 - 6) * TILE2 + TB + w * 1024)); } }
        }
        __syncthreads();
#undef A_SLOT
#pragma unroll
        for (int s = 0; s < 2; ++s)
#pragma unroll
            for (int dt = 0; dt < 4; ++dt) ot[s][dt] = oc[s][dt] * gate[s][0];
    }
    }
#ifndef NSA_COMPACT
#define NSA_COMPACT 1
#endif
    const bool cpath = (flags & 4) && !(flags & 512) && (NSA_COMPACT != 0);
    if (cpath) {
        const int ntd = qt + 1 < 3 ? qt + 1 : 3; const int dl[3] = {0, qt >= 2 ? qt - 1 : 1, qt};
#pragma unroll
        for (int k = 0; k < 3; ++k) if (k < ntd) {
            glds16(KS + (ptrdiff_t)dl[k] * 4096 + dsrc, (unsigned)__builtin_amdgcn_readfirstlane(ldsb + k * TILE2 + w * 1024));
            glds16(VS + (ptrdiff_t)dl[k] * 4096 + dsrc, (unsigned)__builtin_amdgcn_readfirstlane(ldsb + k * TILE2 + TB + w * 1024)); }
    }
    if (flags & 2) {
        unsigned long long ulo[2] = {0ull, 0ull}, uhi[2] = {0ull, 0ull};
        if (qt < 16) {
            const unsigned long long m = (1ull << (qt + 1)) - 1ull;
            if (lane < 8) { selm[(8 * w + lane) * 4 + 0] = (unsigned)m; selm[(8 * w + lane) * 4 + 1] = 0u; selm[(8 * w + lane) * 4 + 2] = 0u; selm[(8 * w + lane) * 4 + 3] = 0u; }
            ulo[0] = m; ulo[1] = m;
        } else {
            unsigned k0[8], k1[8], T[8];
#pragma unroll
            for (int tk = 0; tk < 8; ++tk) { const int tl = 8 * w + tk; const float s0 = scb[tl * 128 + lane], s1 = scb[tl * 128 + 64 + lane];
                const int j0 = lane, j1 = lane + 64;
                k0[tk] = (j0 >= 1 && j0 <= qt - 2) ? __float_as_uint(s0) + 1u : 0u; k1[tk] = (j1 >= 1 && j1 <= qt - 2) ? __float_as_uint(s1) + 1u : 0u; T[tk] = 0u; }
            unsigned done = 0u;
            for (int bit = 30; bit >= 0 && done != 0xFFu; --bit) {
#pragma unroll
                for (int tk = 0; tk < 8; ++tk) { if ((done >> tk) & 1u) continue; const unsigned cand = T[tk] | (1u << bit);
                    const int cnt = __popcll(__ballot(k0[tk] >= cand)) + __popcll(__ballot(k1[tk] >= cand));
                    if (cnt >= 13) T[tk] = cand; if (cnt == 13) done |= 1u << tk; }
            }
#pragma unroll
            for (int tk = 0; tk < 8; ++tk) {
                unsigned long long lo = __ballot(k0[tk] > T[tk]), hi = __ballot(k1[tk] > T[tk]);
                unsigned long long e0 = __ballot(k0[tk] == T[tk]), e1 = __ballot(k1[tk] == T[tk]);
                int need = 13 - (__popcll(lo) + __popcll(hi));
                while (need > 0 && (e0 | e1)) { if (e0) { const unsigned long long bbit = e0 & (0ull - e0); lo |= bbit; e0 ^= bbit; } else { const unsigned long long bbit = e1 & (0ull - e1); hi |= bbit; e1 ^= bbit; } --need; }
                lo |= 1ull;
                if (qt - 1 < 64) lo |= 1ull << (qt - 1); else hi |= 1ull << (qt - 1 - 64);
                if (qt < 64) lo |= 1ull << qt; else hi |= 1ull << (qt - 64);
                if (lane == 0) { const int tl = 8 * w + tk; selm[tl * 4 + 0] = (unsigned)lo; selm[tl * 4 + 1] = (unsigned)(lo >> 32); selm[tl * 4 + 2] = (unsigned)hi; selm[tl * 4 + 3] = (unsigned)(hi >> 32); }
                ulo[tk >> 2] |= lo; uhi[tk >> 2] |= hi;
            }
        }
        if (lane == 0) {
#pragma unroll
            for (int s = 0; s < 2; ++s) { uni[(w * 2 + s) * 4 + 0] = (unsigned)ulo[s]; uni[(w * 2 + s) * 4 + 1] = (unsigned)(ulo[s] >> 32); uni[(w * 2 + s) * 4 + 2] = (unsigned)uhi[s]; uni[(w * 2 + s) * 4 + 3] = (unsigned)(uhi[s] >> 32); }
        }
    }
    NSA_SYNC();
    bool cdone = false;
    if (cpath) {
        constexpr int OFF_QTAB = 0, OFF_OACC = 49152, OTOK = 261 * 4, OHEAD = 65 * 4, OFF_LACC = OFF_OACC + 64 * OTOK, OFF_REFM = OFF_LACC + 2048, OFF_CCTL = OFF_REFM + 1024;
        LAS int* lfin = (LAS int*)(L + OFF_LACC); LAS int* lcrs = lfin + 256; LAS float* refm = (LAS float*)(L + OFF_REFM); LAS unsigned* cctl = (LAS unsigned*)(L + OFF_CCTL);
        const int ntd = qt + 1 < 3 ? qt + 1 : 3; const int dl[3] = {0, qt >= 2 ? qt - 1 : 1, qt};
        float lB[2] = {0.f, 0.f}; f32x4 negv[2] = {Z4, Z4}; bool first[2] = {true, true};
        f32x4 ob[2][4];
#pragma unroll
        for (int s = 0; s < 2; ++s)
#pragma unroll
            for (int dt = 0; dt < 4; ++dt) ob[s][dt] = Z4;
#pragma unroll 1
        for (int k = 0; k < ntd; ++k) { const int tls1[1] = {k}; const int dk = k == 0 ? 0 : (k == 1 ? dl[1] : dl[2]);
#pragma unroll
            for (int s = 0; s < 2; ++s) kv_tiles<1>(L, tls1, dk - k, ~0u, 0, qt, tlx[s], fq, qf[s], ro0, ro1, tro, negv[s], lB[s], first[s], ob[s]); }
        if (tid == 0) { cctl[0] = 1u; cctl[1] = 0u; }
#pragma unroll
        for (int s = 0; s < 2; ++s) { const int row = tlx[s] * 4 + (n & 3); const float l = fq_sum(lB[s]);
            if (fq == 0) { lfin[row] = __float2int_rn(l * 65536.0f); lcrs[row] = __float2int_rn(l * 256.0f); refm[row] = -negv[s][0]; }
            LAS int* op = (LAS int*)(L + OFF_OACC + tlx[s] * OTOK + (n & 3) * OHEAD) + 4 * fq;
#pragma unroll
            for (int dt = 0; dt < 4; ++dt)
#pragma unroll
                for (int r = 0; r < 4; ++r) op[16 * dt + r] = __float2int_rn(ob[s][dt][r] * 65536.0f); }
        __syncthreads();
#pragma unroll
        for (int s = 0; s < 2; ++s) { const int row = tlx[s] * 4 + (n & 3);
#pragma unroll
            for (int ks = 0; ks < 2; ++ks) *(LAS bf16x8*)(L + OFF_QTAB + row * 128 + (((4 * ks + fq) ^ (row & 7)) << 4)) = qf[s][ks]; }
        __syncthreads();
        f32x4* park = (f32x4*)(args.ws + WS_PARK) + (size_t)blockIdx.x * 8 * 512 + tid;
#pragma unroll
        for (int s = 0; s < 2; ++s)
#pragma unroll
            for (int dt = 0; dt < 4; ++dt) park[(s * 4 + dt) * 512] = ot[s][dt];
        {   const int jmax = qt - 2;
            const bf16* KSF = (const bf16*)(args.ws + WS_KSF) + (size_t)bg * 128 * 4096 + lane * 8; const bf16* VSF = (const bf16*)(args.ws + WS_VSF) + (size_t)bg * 128 * 4096 + lane * 8;
            int j = 0x7fffffff;
            { unsigned jj_ = 0u; if (lane == 0) jj_ = __hip_atomic_fetch_add(cctl, 1u, __ATOMIC_RELAXED, __HIP_MEMORY_SCOPE_WORKGROUP); j = (int)__builtin_amdgcn_readfirstlane(jj_); }
            bf16x8 kfr[8], kfn[8], vfr[8];
            if (j <= jmax) {
#pragma unroll
                for (int f = 0; f < 8; ++f) kfr[f] = *(const GAS bf16x8*)(KSF + (size_t)j * 4096 + f * 512); }
            while (j <= jmax) {
                int jn; { unsigned jj_ = 0u; if (lane == 0) jj_ = __hip_atomic_fetch_add(cctl, 1u, __ATOMIC_RELAXED, __HIP_MEMORY_SCOPE_WORKGROUP); jn = (int)__builtin_amdgcn_readfirstlane(jj_); }
#pragma unroll
                for (int f = 0; f < 8; ++f) vfr[f] = *(const GAS bf16x8*)(VSF + (size_t)j * 4096 + f * 512);
                if (jn <= jmax) {
#pragma unroll
                    for (int f = 0; f < 8; ++f) kfn[f] = *(const GAS bf16x8*)(KSF + (size_t)jn * 4096 + f * 512); }
                unsigned long long hm = __ballot((selm[lane * 4 + (j >> 5)] >> (j & 31)) & 1u);
                int tkc = 0, rowc = 0; bool validc = false; bf16x8 q0, q1; float cv = NEGBIG;
#define CX_PICK() do { int t0g = __builtin_ctzll(hm), t1g = -1, t2g = -1, t3g = -1; hm &= hm - 1ull; \
                    if (hm) { t1g = __builtin_ctzll(hm); hm &= hm - 1ull; } if (hm) { t2g = __builtin_ctzll(hm); hm &= hm - 1ull; } if (hm) { t3g = __builtin_ctzll(hm); hm &= hm - 1ull; } \
                    const int cs_ = n >> 2; const int myt_ = cs_ == 0 ? t0g : cs_ == 1 ? t1g : cs_ == 2 ? t2g : t3g; validc = myt_ >= 0; tkc = validc ? myt_ : t0g; rowc = tkc * 4 + (n & 3); \
                    q0 = *(const LAS bf16x8*)(L + OFF_QTAB + rowc * 128 + ((fq ^ (rowc & 7)) << 4)); q1 = *(const LAS bf16x8*)(L + OFF_QTAB + rowc * 128 + (((4 + fq) ^ (rowc & 7)) << 4)); \
                    cv = validc ? 16.0f - refm[rowc] : NEGBIG; } while (0)
                bool more = hm != 0ull;
                if (more) CX_PICK();
                while (more) {
                    const f32x4 cin = {cv, cv, cv, cv};
                    f32x4 sv[4];
#pragma unroll
                    for (int mt = 0; mt < 4; ++mt) sv[mt] = NSA_MFMA(kfr[2 * mt], q0, cin);
#pragma unroll
                    for (int mt = 0; mt < 4; ++mt) sv[mt] = NSA_MFMA(kfr[2 * mt + 1], q1, sv[mt]);
                    const int tk = tkc, row = rowc; const bool valid = validc;
                    f32x2_t ls2 = {0.f, 0.f};
#pragma unroll
                    for (int mt = 0; mt < 4; ++mt) {
#pragma unroll
                        for (int r = 0; r < 4; ++r) sv[mt][r] = EX2(sv[mt][r]);
                        ls2 += (f32x2_t){sv[mt][0], sv[mt][1]}; ls2 += (f32x2_t){sv[mt][2], sv[mt][3]}; }
                    const float lsum = ls2[0] + ls2[1];
                    if (__any(!(lsum < 2048.0f * 65536.0f))) { if (lane == 0) cctl[1] = 1u; }
                    bf16x8 pk[2]; pack_p(pk, sv);
                    more = hm != 0ull;
                    if (more) CX_PICK();
                    f32x4 o[4] = {Z4, Z4, Z4, Z4};
#pragma unroll
                    for (int jj = 0; jj < 2; ++jj)
#pragma unroll
                        for (int dt = 0; dt < 4; ++dt) o[dt] = NSA_MFMA(vfr[2 * dt + jj], pk[jj], o[dt]);
                    const float lrow = fq_sum(lsum);
#ifndef NSA_CX_NOATOM
                    if (valid) { LAS int* op = (LAS int*)(L + OFF_OACC + tk * OTOK + (n & 3) * OHEAD) + 4 * fq;
#pragma unroll
                        for (int dt = 0; dt < 4; ++dt)
#pragma unroll
                            for (int r = 0; r < 4; ++r) (void)__hip_atomic_fetch_add(op + 16 * dt + r, cvt_rpi(o[dt][r]), __ATOMIC_RELAXED, __HIP_MEMORY_SCOPE_WORKGROUP);
                        if (fq == 0) { (void)__hip_atomic_fetch_add(lfin + row, cvt_rpi(lrow), __ATOMIC_RELAXED, __HIP_MEMORY_SCOPE_WORKGROUP);
                                       (void)__hip_atomic_fetch_add(lcrs + row, cvt_rpi(lrow * (1.0f / 256.0f)), __ATOMIC_RELAXED, __HIP_MEMORY_SCOPE_WORKGROUP); } }
#else
                    asm volatile("" :: "v"(o[0]), "v"(o[1]), "v"(o[2]), "v"(o[3]), "v"(lrow));
#endif
                }
#undef CX_PICK
#pragma unroll
                for (int f = 0; f < 8; ++f) kfr[f] = kfn[f];
                j = jn;
            }
        }
        __syncthreads();
        const float vmax_g = ((const float*)(args.ws + WS_VMAX))[bg];
#pragma unroll
        for (int s = 0; s < 2; ++s) {
#pragma unroll
            for (int dt = 0; dt < 4; ++dt) ot[s][dt] = park[(s * 4 + dt) * 512];
            const bf16* qp = NQp + grow[s] * 512 + (g * 4 + (n & 3)) * 64 + 8 * fq; qf[s][0] = *(const GAS bf16x8*)qp; qf[s][1] = *(const GAS bf16x8*)(qp + 32); }
        {
            const float vmax = vmax_g; const float lim = 16000.0f / fmaxf(vmax, 1.0f);
            bool bad = false;
#pragma unroll
            for (int s = 0; s < 2; ++s) bad = bad || ((float)lcrs[tlx[s] * 4 + (n & 3)] * (1.0f / 256.0f) >= lim);
            if (__any(bad)) { if (lane == 0) cctl[1] = 1u; }
        }
        __syncthreads();
        cdone = cctl[1] == 0u && (NSA_COMPACT == 1);
        __builtin_amdgcn_s_waitcnt(0x0F70);
        if (cdone) {
#pragma unroll
            for (int s = 0; s < 2; ++s) { const int row = tlx[s] * 4 + (n & 3); const float sc = gate[s][1] / (float)lfin[row];
                const LAS int* op = (const LAS int*)(L + OFF_OACC + tlx[s] * OTOK + (n & 3) * OHEAD) + 4 * fq;
#pragma unroll
                for (int dt = 0; dt < 4; ++dt)
#pragma unroll
                    for (int r = 0; r < 4; ++r) ot[s][dt][r] += (float)op[16 * dt + r] * sc; }
        }
        __syncthreads();
    }
#ifndef NSA_DREP
#define NSA_DREP 1
#endif
#pragma unroll 1
    for (int rep = 0; rep < NSA_DREP; ++rep)
#pragma unroll 1
    for (int br = cdone ? 1 : 0; br < 2; ++br) {
        if (!((flags >> (2 + br)) & 1)) continue;
        const int i_begin = br == 0 ? 0 : (qt >= 8 ? 0 : 8 - qt), i_end = br == 0 ? qt + 1 : 9;
        const bf16* Kg = br == 0 ? KS : KW + (ptrdiff_t)(t0 - 512) * 64; const bf16* Vg = br == 0 ? VS : VW + (ptrdiff_t)(t0 - 512) * 64;
        const int nst = (i_end - i_begin + 3) >> 2;
        unsigned mym[2][4] = {{~0u, ~0u, ~0u, ~0u}, {~0u, ~0u, ~0u, ~0u}}, unm[2][4] = {{~0u, ~0u, ~0u, ~0u}, {~0u, ~0u, ~0u, ~0u}};
        if (br == 0) {
#pragma unroll
            for (int s = 0; s < 2; ++s)
#pragma unroll
                for (int k = 0; k < 4; ++k) { mym[s][k] = selm[tlx[s] * 4 + k]; unm[s][k] = __builtin_amdgcn_readfirstlane(uni[(w * 2 + s) * 4 + k]); } }
        float lB[2] = {0.f, 0.f}; f32x4 negv[2] = {Z4, Z4}; bool first[2] = {true, true};
        const f32x4 NEGV = {NEGBIG, NEGBIG, NEGBIG, NEGBIG};
        f32x4 ob[2][4];
#pragma unroll
        for (int s = 0; s < 2; ++s)
#pragma unroll
            for (int dt = 0; dt < 4; ++dt) ob[s][dt] = Z4;
        NSA_DMA(4, L, Kg, Vg, i_begin, i_end, true);
        NSA_SYNC();
        for (int st = 0; st < nst; ++st) {
            const int ib = i_begin + 4 * st;
            if (st + 1 < nst) NSA_DMA(4, L + ((st + 1) & 1) * 65536, Kg, Vg, ib + 4, i_end, true);
            const LAS unsigned char* slot = L + (st & 1) * 65536;
#pragma unroll
            for (int s = 0; s < 2; ++s) {
                const int wsel = ib >> 5, sh = ib & 31;
                const unsigned uwd = wsel == 0 ? unm[s][0] : wsel == 1 ? unm[s][1] : wsel == 2 ? unm[s][2] : unm[s][3];
                const unsigned mwd = wsel == 0 ? mym[s][0] : wsel == 1 ? mym[s][1] : wsel == 2 ? mym[s][2] : mym[s][3];
                const unsigned ubits = (uwd >> sh) & 15u, mbits = (mwd >> sh) & 15u;
                unsigned bits = ubits & ((i_end - ib >= 4) ? 15u : ((1u << (i_end - ib)) - 1u));
                if (flags & 16) bits = 0u;
                while (bits) {
                    const int ta = __builtin_ctz(bits); bits &= bits - 1u;
#ifdef NSA_DUAL
                    if (!first[s] && bits) { const int tb = __builtin_ctz(bits); bits &= bits - 1u; const int tls2[2] = {ta, tb};
                        kv_tiles<2>(slot, tls2, ib, mbits, br, qt, tlx[s], fq, qf[s], ro0, ro1, tro, negv[s], lB[s], first[s], ob[s]); }
                    else
#endif
                    { const int tls1[1] = {ta};
                        kv_tiles<1>(slot, tls1, ib, mbits, br, qt, tlx[s], fq, qf[s], ro0, ro1, tro, negv[s], lB[s], first[s], ob[s]); }
                }
            }
            NSA_SYNC();
        }
#pragma unroll
        for (int s = 0; s < 2; ++s) { const float l = fq_sum(lB[s]); const float sc = (rep > 0 ? 0.f : 1.f) * (br == 0 ? gate[s][1] : gate[s][2]) / l;
#pragma unroll
            for (int dt = 0; dt < 4; ++dt) ot[s][dt] = ot[s][dt] + ob[s][dt] * sc; }
    }
#ifdef DIAG_SEL
    if (flags == 15 && tid == 0) { unsigned* dg = (unsigned*)(args.ws + 768 * 1024);
        atomicAdd(dg + 0, dq >> 4); atomicAdd(dg + 1, dsx >> 4); atomicAdd(dg + 2, dp >> 4); atomicAdd(dg + 3, dn); }
#endif
#pragma unroll
    for (int s = 0; s < 2; ++s) { bf16* op = (bf16*)(args.ws + yoff) + grow[s] * 512 + (g * 4 + (n & 3)) * 64 + 4 * fq;
#pragma unroll
        for (int dt = 0; dt < 4; ++dt) { u32x2_t wv; wv.x = cvtpk(ot[s][dt][0], ot[s][dt][1]); wv.y = cvtpk(ot[s][dt][2], ot[s][dt][3]); *(GAS u32x2_t*)(op + 16 * dt) = wv; } }
#undef NSA_DMA
#undef NSA_SYNC
}
#undef NSA_MFMA
#undef EX2
}

constexpr size_t WS_GPB = 46 * MiB, WS_GPG = WS_GPB + 512 * 1024, WS_GPPM = WS_GPG + 512 * 1024, WS_GPW = WS_GPPM + 512 * 1024;
constexpr size_t WS_GPMC = 1 * MiB + 64 * 1024, WS_GPBL = WS_GPMC + 8192, WS_GPGM = WS_GPBL + 8192;
constexpr size_t WS_NST = 37 * MiB;
namespace mls {
using nsa::f32x4; using nsa::bf16x8; using nsa::s16x4; using nsa::u32x4_t; using nsa::u32x2_t; using nsa::cvtpk; using nsa::tr4;
#define MLS_MFMA(a, b, c) __builtin_amdgcn_mfma_f32_16x16x32_bf16(a, b, c, 0, 0, 0)
__device__ __forceinline__ bf16x8 rowfrag(const LAS unsigned char* tile, int rs, int row, int ks, int lane) { return *(const LAS bf16x8*)(tile + row * rs + ks * 64 + (lane >> 4) * 16); }
__device__ __forceinline__ bf16x8 trfrag_nat(const LAS unsigned char* tile, int rs, int col0, int ks, int lane) {
    const int i = lane & 15, fq = lane >> 4, q = i >> 2, p = i & 3;
    const LAS unsigned char* a0 = tile + (32 * ks + 8 * fq + q) * rs + (col0 + 4 * p) * 2;
    const s16x4 lo = tr4(a0), hi = tr4(a0 + 4 * rs);
    return (bf16x8){lo[0], lo[1], lo[2], lo[3], hi[0], hi[1], hi[2], hi[3]};
}
__device__ __forceinline__ float logsig(float x) { return fminf(x, 0.f) - log1pf(__expf(-fabsf(x))); }

__device__ __forceinline__ void gate_chunk(const Args& args, int bh, int c, int lane) {
    const int b = bh >> 2, h = bh & 3; const float fb = args.in[4][h];
    const float* MISCB = (const float*)(args.ws + WS_MISC);
    const int t = c * 64 + lane; const size_t row = (size_t)b * 8192 + t;
    const float li = MISCB[row * 32 + h], lf = logsig(MISCB[row * 32 + 4 + h] + fb);
    float bc = lf;
#pragma unroll
    for (int o = 1; o < 64; o <<= 1) { const float v = __shfl_up(bc, o); if (lane >= o) bc += v; }
    const float g = li - bc; float px = g;
#pragma unroll
    for (int o = 1; o < 64; o <<= 1) { const float v = __shfl_up(px, o); if (lane >= o) px = fmaxf(px, v); }
    ((float*)(args.ws + WS_GPB))[bh * 8192 + t] = bc; ((float*)(args.ws + WS_GPG))[bh * 8192 + t] = g; ((float*)(args.ws + WS_GPPM))[bh * 8192 + t] = px;
    if (lane == 63) { ((float*)(args.ws + WS_GPBL))[bh * 128 + c] = bc; ((float*)(args.ws + WS_GPGM))[bh * 128 + c] = px; }
}
__device__ __forceinline__ void gate_scan2(const Args& args, int bh, int lane, LAS float* mcs, LAS float* p63, bool store) {
    const float* GPBL = (const float*)(args.ws + WS_GPBL) + bh * 128; const float* GPGM = (const float*)(args.ws + WS_GPGM) + bh * 128;
    const float bl0 = GPBL[lane], bl1 = GPBL[64 + lane], gm0 = GPGM[lane], gm1 = GPGM[64 + lane];
    float m = 0.f, mc0 = 0.f, mc1 = 0.f, pp0 = 0.f, pp1 = 0.f;
    for (int c = 0; c < 64; ++c) { const float bl = __shfl(bl0, c), gm = __shfl(gm0, c); const float p = fmaxf(m, gm); if (lane == c) { mc0 = m; pp0 = p; } m = bl + p; }
    for (int c = 0; c < 64; ++c) { const float bl = __shfl(bl1, c), gm = __shfl(gm1, c); const float p = fmaxf(m, gm); if (lane == c) { mc1 = m; pp1 = p; } m = bl + p; }
    mcs[lane] = mc0; mcs[64 + lane] = mc1; p63[lane] = pp0; p63[64 + lane] = pp1;
    if (store) { float* GPMC = (float*)(args.ws + WS_GPMC) + bh * 128; GPMC[lane] = mc0; GPMC[64 + lane] = mc1; }
}

constexpr int SC_KRS = 272, SC_VRS = 272, SC_KT = 64 * SC_KRS, SC_VT = 64 * SC_VRS, SC_SLOT = SC_KT + SC_VT + 256, SC_NT = 8;
__device__ __forceinline__ void state_scan(const Args& args, LAS unsigned char* L, int bh, int sl, int tid) {
    const int lane = tid & 63, w = __builtin_amdgcn_readfirstlane(tid >> 6), n = lane & 15, fq = lane >> 4;
    const int b = bh >> 2, h = bh & 3;
    const bf16* KMp = (const bf16*)(args.ws + WS_KM) + (size_t)bh * 8192 * 128;
    const bf16* VMp = (const bf16*)(args.ws + WS_VM) + (size_t)b * 8192 * 1024 + h * 256 + sl * 128;
    const float* GPG = (const float*)(args.ws + WS_GPG) + bh * 8192;
    LAS float* mcs = (LAS float*)(L + 2 * SC_SLOT); LAS float* p63 = mcs + 128;
    __syncthreads();
    if (w == 0) gate_scan2(args, bh, lane, mcs, p63, sl == 0);
    __syncthreads();
    bf16* CST = (bf16*)args.out + (size_t)bh * 128 * 32768;
    float* NST = (float*)(args.ws + WS_NST) + (size_t)bh * 128 * 128;
    const f32x4 Z4 = {0.f, 0.f, 0.f, 0.f};
    f32x4 acc[SC_NT], accn = Z4;
#pragma unroll
    for (int nt = 0; nt < SC_NT; ++nt) acc[nt] = Z4;
    struct SReg { v4u k0, k1, v0, v1; float w; };
    SReg ra, rb, rc, rd;
#define SC_LOAD(R, cc) do { const bf16* kc_ = KMp + (size_t)(cc) * 64 * 128; (R).k0 = *(const GAS v4u*)(kc_ + tid * 8); (R).k1 = *(const GAS v4u*)(kc_ + (tid + 512) * 8); \
        (R).v0 = *(const GAS v4u*)(VMp + (size_t)((cc) * 64 + (tid >> 4)) * 1024 + (tid & 15) * 8); (R).v1 = *(const GAS v4u*)(VMp + (size_t)((cc) * 64 + 32 + (tid >> 4)) * 1024 + (tid & 15) * 8); (R).w = 0.f; if (tid < 64) (R).w = __expf(GPG[(cc) * 64 + tid] - p63[cc]); } while (0)
#define SC_STORE(R, slot) do { LAS unsigned char* D_ = L + (slot) * SC_SLOT; *(LAS v4u*)(D_ + (tid >> 4) * SC_KRS + (tid & 15) * 16) = (R).k0; *(LAS v4u*)(D_ + ((tid + 512) >> 4) * SC_KRS + (tid & 15) * 16) = (R).k1; \
        *(LAS v4u*)(D_ + SC_KT + (tid >> 4) * SC_VRS + (tid & 15) * 16) = (R).v0; *(LAS v4u*)(D_ + SC_KT + (32 + (tid >> 4)) * SC_VRS + (tid & 15) * 16) = (R).v1; if (tid < 64) ((LAS float*)(D_ + SC_KT + SC_VT))[tid] = (R).w; } while (0)
#define SC_STEP(c, RL, RS) do { \
        if ((c) + 4 < 128) SC_LOAD(RL, (c) + 4); \
        { bf16* cs = CST + (size_t)(c) * 32768 + (size_t)(sl * 128 + n) * 128 + 16 * w + 4 * fq; \
          _Pragma("unroll") for (int nt = 0; nt < SC_NT; ++nt) { u32x2_t wv; wv.x = cvtpk(acc[nt][0], acc[nt][1]); wv.y = cvtpk(acc[nt][2], acc[nt][3]); *(GAS u32x2_t*)(cs + (size_t)nt * 16 * 128) = wv; } \
          if (sl == 0 && n == 0) *(GAS f32x4*)(NST + (c) * 128 + 16 * w + 4 * fq) = accn; } \
        const LAS unsigned char* S = L + ((c) & 1) * SC_SLOT; const LAS unsigned char* Kt = S; const LAS unsigned char* Vt = S + SC_KT; const LAS float* wl = (const LAS float*)(S + SC_KT + SC_VT); \
        const float dec = __expf(mcs[c] - p63[c]); \
        _Pragma("unroll") for (int nt = 0; nt < SC_NT; ++nt) acc[nt] = acc[nt] * dec; \
        accn = accn * dec; \
        _Pragma("unroll") for (int ks = 0; ks < 2; ++ks) { \
            const s16x4 klo = tr4(Kt + kbase + ks * 32 * SC_KRS), khi = tr4(Kt + kbase + ks * 32 * SC_KRS + 4 * SC_KRS); \
            const f32x4 w0 = *(const LAS f32x4*)(wl + 32 * ks + 8 * fq), w1 = *(const LAS f32x4*)(wl + 32 * ks + 8 * fq + 4); \
            bf16x8 vf[SC_NT]; \
            _Pragma("unroll") for (int nt = 0; nt < SC_NT; ++nt) { const s16x4 a_ = tr4(Vt + vbase + nt * 32 + ks * 32 * SC_VRS), b_ = tr4(Vt + vbase + nt * 32 + ks * 32 * SC_VRS + 4 * SC_VRS); \
                vf[nt] = (bf16x8){a_[0], a_[1], a_[2], a_[3], b_[0], b_[1], b_[2], b_[3]}; } \
              \
            u32x4_t aw; aw.x = cvtpk(bf2f((bf16)klo[0]) * w0[0], bf2f((bf16)klo[1]) * w0[1]); aw.y = cvtpk(bf2f((bf16)klo[2]) * w0[2], bf2f((bf16)klo[3]) * w0[3]); \
            aw.z = cvtpk(bf2f((bf16)khi[0]) * w1[0], bf2f((bf16)khi[1]) * w1[1]); aw.w = cvtpk(bf2f((bf16)khi[2]) * w1[2], bf2f((bf16)khi[3]) * w1[3]); \
            const bf16x8 af = __builtin_bit_cast(bf16x8, aw); \
            accn = MLS_MFMA(af, onesf, accn); \
            _Pragma("unroll") for (int nt = 0; nt < SC_NT; ++nt) acc[nt] = MLS_MFMA(af, vf[nt], acc[nt]); } \
        if ((c) + 1 < 128) SC_STORE(RS, ((c) + 1) & 1); \
        __syncthreads(); } while (0)
    const int kbase = (8 * fq + (n >> 2)) * SC_KRS + (16 * w + 4 * (n & 3)) * 2, vbase = (8 * fq + (n >> 2)) * SC_VRS + (4 * (n & 3)) * 2;
    u32x4_t one_; one_.x = one_.y = one_.z = one_.w = (n == 0) ? 0x3f803f80u : 0u; const bf16x8 onesf = __builtin_bit_cast(bf16x8, one_);
    SC_LOAD(ra, 0); SC_LOAD(rb, 1); SC_LOAD(rc, 2); SC_LOAD(rd, 3);
    __syncthreads();
    SC_STORE(ra, 0);
    __syncthreads();
    for (int c = 0; c < 128; c += 4) { SC_STEP(c, ra, rb); SC_STEP(c + 1, rb, rc); SC_STEP(c + 2, rc, rd); SC_STEP(c + 3, rd, ra); }
#undef SC_LOAD
#undef SC_STORE
#undef SC_STEP
}

constexpr int OU_QRS = 272, OU_VRS = 528, OU_SRS = 144;
constexpr int OU_Q = 0, OU_K = OU_Q + 64 * OU_QRS, OU_V = OU_K + 64 * OU_QRS, OU_SW = OU_V + 64 * OU_VRS, OU_SC = OU_SW + 64 * OU_SRS;
struct OutPF { v4u q0, q1, k0, k1, vv[4]; bf16x8 cf[2][4]; float s0, s1, s2, mc; };
__device__ __forceinline__ void out_prefetch(OutPF& pf, const Args& args, int bh, int c, int tid) {
    const int lane = tid & 63, w = __builtin_amdgcn_readfirstlane(tid >> 6), n = lane & 15, fq = lane >> 4;
    const int b = bh >> 2, h = bh & 3; const size_t row0 = (size_t)b * 8192 + c * 64;
    const bf16* QMp = (const bf16*)(args.ws + WS_QM) + ((size_t)bh * 8192 + c * 64) * 128; const bf16* KMp = (const bf16*)(args.ws + WS_KM) + ((size_t)bh * 8192 + c * 64) * 128;
    const bf16* VMp = (const bf16*)(args.ws + WS_VM) + row0 * 1024 + h * 256;
    const bf16* CST = (const bf16*)args.out + ((size_t)bh * 128 + c) * 32768; const float* NST = (const float*)(args.ws + WS_NST) + ((size_t)bh * 128 + c) * 128;
    pf.q0 = *(const GAS v4u*)(QMp + tid * 8); pf.q1 = *(const GAS v4u*)(QMp + (tid + 512) * 8); pf.k0 = *(const GAS v4u*)(KMp + tid * 8); pf.k1 = *(const GAS v4u*)(KMp + (tid + 512) * 8);
#pragma unroll
    for (int i = 0; i < 4; ++i) { const int p = tid + 512 * i; pf.vv[i] = *(const GAS v4u*)(VMp + (size_t)(p >> 5) * 1024 + (p & 31) * 8); }
#pragma unroll
    for (int mi = 0; mi < 2; ++mi)
#pragma unroll
        for (int ks = 0; ks < 4; ++ks) pf.cf[mi][ks] = *(const GAS bf16x8*)(CST + (size_t)(32 * w + 16 * mi + n) * 128 + 32 * ks + 8 * fq);
    pf.s0 = 0.f; pf.s1 = 0.f; pf.s2 = 0.f;
    if (tid < 64) { const int t = bh * 8192 + c * 64 + tid; pf.s0 = ((const float*)(args.ws + WS_GPG))[t]; pf.s1 = ((const float*)(args.ws + WS_GPPM))[t]; pf.s2 = ((const float*)(args.ws + WS_GPB))[t]; }
    else if (tid < 192) pf.s0 = NST[tid - 64];
    pf.mc = ((const float*)(args.ws + WS_GPMC))[bh * 128 + c];
}
__device__ __forceinline__ void out_unit(const Args& args, LAS unsigned char* L, int bh, int c, int tid, OutPF& pf, bool has_next, int nbh, int nc, const size_t yoff = WS_YA) {
    const int lane = tid & 63, w = __builtin_amdgcn_readfirstlane(tid >> 6), n = lane & 15, fq = lane >> 4;
    const int b = bh >> 2, h = bh & 3; const size_t row0 = (size_t)b * 8192 + c * 64;
    const bf16* OGp = (const bf16*)(args.ws + WS_OG) + row0 * 1024 + h * 256;
    bf16* YAp = (bf16*)(args.ws + yoff) + row0 * 1024 + h * 256;
    LAS unsigned char* Qt = L + OU_Q; LAS unsigned char* Kt = L + OU_K; LAS unsigned char* Vt = L + OU_V; LAS unsigned char* SW = L + OU_SW;
    LAS float* gls = (LAS float*)(L + OU_SC); LAS float* pms = gls + 64; LAS float* bcs = pms + 64; LAS float* nvec = bcs + 64; LAS float* nqv = nvec + 128; LAS float* ssq = nqv + 64;
    const f32x4 Z4 = {0.f, 0.f, 0.f, 0.f};
    __syncthreads();
    const float mc = pf.mc;
    *(LAS v4u*)(Qt + (tid >> 4) * OU_QRS + (tid & 15) * 16) = pf.q0; *(LAS v4u*)(Qt + ((tid + 512) >> 4) * OU_QRS + (tid & 15) * 16) = pf.q1;
    *(LAS v4u*)(Kt + (tid >> 4) * OU_QRS + (tid & 15) * 16) = pf.k0; *(LAS v4u*)(Kt + ((tid + 512) >> 4) * OU_QRS + (tid & 15) * 16) = pf.k1;
#pragma unroll
    for (int i = 0; i < 4; ++i) { const int p = tid + 512 * i; *(LAS v4u*)(Vt + (p >> 5) * OU_VRS + (p & 31) * 16) = pf.vv[i]; }
    if (tid < 64) { gls[tid] = pf.s0; pms[tid] = fmaxf(mc, pf.s1); bcs[tid] = pf.s2; }
    else if (tid < 192) nvec[tid - 64] = pf.s0;
    bf16x8 cf[2][4];
#pragma unroll
    for (int mi = 0; mi < 2; ++mi)
#pragma unroll
        for (int ks = 0; ks < 4; ++ks) cf[mi][ks] = pf.cf[mi][ks];
    u32x2_t ogr[4][2];
#pragma unroll
    for (int nt = 0; nt < 4; ++nt)
#pragma unroll
        for (int mi = 0; mi < 2; ++mi) ogr[nt][mi] = *(const GAS u32x2_t*)(OGp + (size_t)(16 * nt + n) * 1024 + 32 * w + 16 * mi + 4 * fq);
    f32x4 gvr[2];
    { const float* ng0 = args.in[7] + h * 256;
#pragma unroll
      for (int mi = 0; mi < 2; ++mi) gvr[mi] = *(const GAS f32x4*)(ng0 + 32 * w + 16 * mi + 4 * fq); }
    if (has_next) out_prefetch(pf, args, nbh, nc, tid);
    __syncthreads();
#pragma unroll
    for (int k2 = 0; k2 < 2; ++k2) { const int idx = 2 * w + k2, mt = idx >> 2, nt = idx & 3;
        f32x4 sv = Z4;
        if (mt <= nt) {
#pragma unroll
            for (int ks = 0; ks < 4; ++ks) sv = MLS_MFMA(rowfrag(Kt, OU_QRS, 16 * mt + n, ks, lane), rowfrag(Qt, OU_QRS, 16 * nt + n, ks, lane), sv);
            const int t = 16 * nt + n; const float pmt = pms[t];
#pragma unroll
            for (int r = 0; r < 4; ++r) { const int s = 16 * mt + 4 * fq + r; sv[r] = (s <= t) ? sv[r] * __expf(gls[s] - pmt) : 0.f; }
        }
        u32x2_t wv; wv.x = cvtpk(sv[0], sv[1]); wv.y = cvtpk(sv[2], sv[3]);
        *(LAS u32x2_t*)(SW + (16 * nt + n) * OU_SRS + (16 * mt + 4 * fq) * 2) = wv; }
    __syncthreads();
    f32x4 acc[2][4], accx = Z4;
#pragma unroll
    for (int mi = 0; mi < 2; ++mi)
#pragma unroll
        for (int nt = 0; nt < 4; ++nt) acc[mi][nt] = Z4;
#pragma unroll
    for (int nt = 0; nt < 4; ++nt)
#pragma unroll
        for (int ks = 0; ks < 4; ++ks) { const bf16x8 qb = rowfrag(Qt, OU_QRS, 16 * nt + n, ks, lane);
            acc[0][nt] = MLS_MFMA(cf[0][ks], qb, acc[0][nt]); acc[1][nt] = MLS_MFMA(cf[1][ks], qb, acc[1][nt]); }
    if (w < 4) {
#pragma unroll
        for (int ks = 0; ks < 4; ++ks) { const f32x4 n0 = *(const LAS f32x4*)(nvec + 32 * ks + 8 * fq), n1 = *(const LAS f32x4*)(nvec + 32 * ks + 8 * fq + 4);
            u32x4_t pw; pw.x = cvtpk(n0[0], n0[1]); pw.y = cvtpk(n0[2], n0[3]); pw.z = cvtpk(n1[0], n1[1]); pw.w = cvtpk(n1[2], n1[3]);
            if (n != 0) { pw.x = 0u; pw.y = 0u; pw.z = 0u; pw.w = 0u; }
            accx = MLS_MFMA(__builtin_bit_cast(bf16x8, pw), rowfrag(Qt, OU_QRS, 16 * w + n, ks, lane), accx); }
        accx = accx * __expf(mc - pms[16 * w + n]);
    }
#pragma unroll
    for (int nt = 0; nt < 4; ++nt) { const float wi = __expf(mc - pms[16 * nt + n]); acc[0][nt] = acc[0][nt] * wi; acc[1][nt] = acc[1][nt] * wi; }
#pragma unroll
    for (int nt = 0; nt < 4; ++nt)
#pragma unroll
        for (int ks = 0; ks < 2; ++ks) { if (32 * ks > 16 * nt + 15) continue;
            const bf16x8 sb = rowfrag(SW, OU_SRS, 16 * nt + n, ks, lane);
            acc[0][nt] = MLS_MFMA(trfrag_nat(Vt, OU_VRS, 32 * w, ks, lane), sb, acc[0][nt]);
            acc[1][nt] = MLS_MFMA(trfrag_nat(Vt, OU_VRS, 32 * w + 16, ks, lane), sb, acc[1][nt]); }
    if (w < 4) {
        u32x4_t one; one.x = one.y = one.z = one.w = (n == 0) ? 0x3f803f80u : 0u;
#pragma unroll
        for (int ks = 0; ks < 2; ++ks) accx = MLS_MFMA(__builtin_bit_cast(bf16x8, one), rowfrag(SW, OU_SRS, 16 * w + n, ks, lane), accx);
        if (fq == 0) nqv[16 * w + n] = accx[0];
    }
    __syncthreads();
#pragma unroll
    for (int nt = 0; nt < 4; ++nt) { const int t = 16 * nt + n; const float den = fmaxf(fabsf(nqv[t]), __expf(-(bcs[t] + pms[t]))), inv = 1.0f / den; float ss = 0.f;
#pragma unroll
        for (int mi = 0; mi < 2; ++mi) { acc[mi][nt] = acc[mi][nt] * inv;
#pragma unroll
            for (int r = 0; r < 4; ++r) ss += acc[mi][nt][r] * acc[mi][nt][r]; }
        ss += __shfl_xor(ss, 16); ss += __shfl_xor(ss, 32);
        if (fq == 0) ssq[w * 64 + t] = ss; }
    __syncthreads();
    const float* ng = args.in[7] + h * 256;
#pragma unroll
    for (int nt = 0; nt < 4; ++nt) { const int t = 16 * nt + n; float tot = 0.f;
#pragma unroll
        for (int ww = 0; ww < 8; ++ww) tot += ssq[ww * 64 + t];
        const float rs = 1.0f / sqrtf(tot * (1.f / 256.f) + RMS_EPS);
#pragma unroll
        for (int mi = 0; mi < 2; ++mi) { const int dv = 32 * w + 16 * mi + 4 * fq;
            const u32x2_t og = ogr[nt][mi]; const f32x4 gv = gvr[mi];
            const f32x4 hv = acc[mi][nt] * rs;
            u32x2_t wv; wv.x = cvtpk(hv[0] * gv[0] * bfl(og.x), hv[1] * gv[1] * bfh(og.x)); wv.y = cvtpk(hv[2] * gv[2] * bfl(og.y), hv[3] * gv[3] * bfh(og.y));
            *(GAS u32x2_t*)(YAp + (size_t)t * 1024 + dv) = wv; } }
}
#undef MLS_MFMA
}

constexpr size_t WS_W1T = 38 * MiB;
constexpr size_t WS_C1 = 512 * 1024;
constexpr size_t WS_W2T = 1 * MiB + 256 * 1024;
namespace cmpm {
using nsa::f32x4; using nsa::bf16x8; using nsa::u32x2_t; using nsa::cvtpk;
constexpr int HRS = 528, HOFF = 32 * 528;
__device__ __forceinline__ void cmp_unit(const Args& args, LAS unsigned char* L, int kind, int bg, int cb, int tid) {
    const int lane = tid & 63, w = __builtin_amdgcn_readfirstlane(tid >> 6), n = lane & 15, fq = lane >> 4;
    const bf16* A = (const bf16*)(args.ws + WS_NKV) + (size_t)kind * pg8::NKV_KIND_ELEMS + ((size_t)bg * 8192 + 16 * 32 * cb) * 64;
    const bf16* W1T = (const bf16*)(args.ws + WS_W1T) + (size_t)kind * 256 * 2048;
    const bf16* W2T = (const bf16*)(args.ws + WS_W2T) + (size_t)kind * 64 * 256;
    const float* c1 = (const float*)(args.ws + WS_C1) + kind * 256;
    bf16* dst = (bf16*)(args.ws + (kind ? WS_VCC : WS_KCC)) + ((size_t)bg * 512 + 32 * cb) * 64;
    const f32x4 Z4 = {0.f, 0.f, 0.f, 0.f};
    f32x4 acc[2][2] = {{Z4, Z4}, {Z4, Z4}};
    const bf16* wp0 = W1T + ((size_t)(2 * w) * 64 + lane) * 8; const bf16* wp1 = wp0 + 64 * 8;
    bf16x8 bw[2][8][2];
#pragma unroll
    for (int i = 0; i < 8; ++i) { bw[0][i][0] = *(const GAS bf16x8*)(wp0 + (size_t)i * 16 * 64 * 8); bw[0][i][1] = *(const GAS bf16x8*)(wp1 + (size_t)i * 16 * 64 * 8); }
    __syncthreads();
    for (int ch = tid; ch < 528 * 8; ch += 512) { const int r = ch >> 3, c16 = ch & 7;
        *(LAS v4u*)(L + HOFF + r * 128 + ((c16 ^ ((r >> 4) & 7)) << 4)) = *(const GAS v4u*)(A + (size_t)r * 64 + c16 * 8); }
    __syncthreads();
#pragma unroll
    for (int kb = 0; kb < 8; ++kb) {
        if (kb + 1 < 8) {
#pragma unroll
            for (int i = 0; i < 8; ++i) { const int ks = 8 * (kb + 1) + i; bw[(kb + 1) & 1][i][0] = *(const GAS bf16x8*)(wp0 + (size_t)ks * 16 * 64 * 8); bw[(kb + 1) & 1][i][1] = *(const GAS bf16x8*)(wp1 + (size_t)ks * 16 * 64 * 8); } }
#pragma unroll
        for (int i = 0; i < 8; ++i) { const int ks = 8 * kb + i; const bf16x8 b0 = bw[kb & 1][i][0], b1 = bw[kb & 1][i][1];
            const int r0 = 16 * n + (ks >> 1), r1 = r0 + 256, c16 = 4 * (ks & 1) + fq;
            const bf16x8 a0 = *(const LAS bf16x8*)(L + HOFF + r0 * 128 + ((c16 ^ ((r0 >> 4) & 7)) << 4)), a1 = *(const LAS bf16x8*)(L + HOFF + r1 * 128 + ((c16 ^ ((r1 >> 4) & 7)) << 4));
            acc[0][0] = __builtin_amdgcn_mfma_f32_16x16x32_bf16(b0, a0, acc[0][0], 0, 0, 0); acc[0][1] = __builtin_amdgcn_mfma_f32_16x16x32_bf16(b0, a1, acc[0][1], 0, 0, 0);
            acc[1][0] = __builtin_amdgcn_mfma_f32_16x16x32_bf16(b1, a0, acc[1][0], 0, 0, 0); acc[1][1] = __builtin_amdgcn_mfma_f32_16x16x32_bf16(b1, a1, acc[1][1], 0, 0, 0); }
    }
    __syncthreads();
#pragma unroll
    for (int nt = 0; nt < 2; ++nt) { const int col = 32 * w + 16 * nt + 4 * fq; const f32x4 cv = *(const GAS f32x4*)(c1 + col);
#pragma unroll
        for (int mt = 0; mt < 2; ++mt) { f32x4 v = acc[nt][mt] + cv;
#pragma unroll
            for (int r = 0; r < 4; ++r) v[r] = v[r] / (1.0f + __expf(-v[r]));
            u32x2_t wv; wv.x = cvtpk(v[0], v[1]); wv.y = cvtpk(v[2], v[3]);
            *(LAS u32x2_t*)(L + (16 * mt + n) * HRS + col * 2) = wv; } }
    __syncthreads();
    { const int mt2 = w >> 2, et = w & 3; f32x4 o = Z4;
#pragma unroll
      for (int ks = 0; ks < 8; ++ks) { const bf16x8 wa = *(const GAS bf16x8*)(W2T + (size_t)(16 * et + n) * 256 + 32 * ks + 8 * fq);
          const bf16x8 hb = *(const LAS bf16x8*)(L + (16 * mt2 + n) * HRS + ks * 64 + fq * 16);
          o = __builtin_amdgcn_mfma_f32_16x16x32_bf16(wa, hb, o, 0, 0, 0); }
      u32x2_t wv; wv.x = cvtpk(o[0], o[1]); wv.y = cvtpk(o[2], o[3]);
      *(GAS u32x2_t*)(dst + (size_t)(16 * mt2 + n) * 64 + 16 * et + 4 * fq) = wv; }
}
}
#ifndef REP_MASK
#define REP_MASK 0
#endif
#ifndef P1_ALIGN
#define P1_ALIGN true
#endif
__global__ void __launch_bounds__(NWAVES * 64, 2) mk_fwd(Args args) {
    extern __shared__ __attribute__((aligned(16))) unsigned char lds[];
    LAS unsigned char* L = (LAS unsigned char*)lds;
    volatile LAS unsigned* MISCW = (volatile LAS unsigned*)(L + MISC_OFF);
    const int tid = threadIdx.x, lane = tid & 63, wave = __builtin_amdgcn_readfirstlane(tid >> 6);
    const int G = gridDim.x; const int bx = blockIdx.x; const int vcu = (G % 8 == 0) ? (bx % 8) * (G / 8) + bx / 8 : bx;
    unsigned char* ws = args.ws;
    gu32* ctl = (gu32*)(ws + WS_CTL);
    for (int u = tid; u < (LDS_BYTES - LDSCTL_OFF) / 4; u += NWAVES * 64) ((LAS unsigned*)(L + LDSCTL_OFF))[u] = 0u;
    __syncthreads();
    const int lo = args.ph_lo, hi = args.ph_hi;
    XcdBarrier bar; bar.bar = (unsigned*)(ctl + CW_BAR); bar.x = 0; bar.st = nullptr;
    if (hi - lo > 1) bar = xcd_barrier_post((unsigned*)(ctl + CW_BAR), MISCW + 8);
#define IN(k) (lo <= (k) && (k) < hi)
#define SEAM(k) do { if (IN(k) && IN((k) + 1)) xcd_barrier(bar); } while (0)

    const float* x = args.in[0];
    bf16* Wt_in = (bf16*)(ws + WS_WIN); bf16* WaT = (bf16*)(ws + WS_WA); bf16* WbT = (bf16*)(ws + WS_WB); bf16* WoT = (bf16*)(ws + WS_WO);
    bf16* WguT = (bf16*)(ws + WS_WGU); bf16* WdT = (bf16*)(ws + WS_WD);
    float* biasp = (float*)(ws + WS_BIASP); float* MISCB = (float*)(ws + WS_MISC);
    float* ssq1 = (float*)(ws + WS_SSQ1); float* ssq2 = (float*)(ws + WS_SSQ2);
    bf16* XN = (bf16*)(ws + WS_XN); bf16* QKR = (bf16*)args.out;     bf16* VM = (bf16*)(ws + WS_VM); bf16* OG = (bf16*)(ws + WS_OG);
    bf16* NQ = (bf16*)(ws + WS_NQ); bf16* NKV = (bf16*)(ws + WS_NKV); bf16* GA = (bf16*)(ws + WS_GA); bf16* GB = (bf16*)(ws + WS_GB);
    bf16* QM = (bf16*)(ws + WS_QM); bf16* KM = (bf16*)(ws + WS_KM);
    bf16* YA = (bf16*)(ws + WS_YA); bf16* YB = (bf16*)(ws + WS_YB); bf16* T1 = (bf16*)(ws + WS_T1); bf16* MERGED = (bf16*)(ws + WS_MERGED);
    bf16* X1B = (bf16*)(ws + WS_X1B); bf16* ACT = (bf16*)(ws + WS_ACT);
    float* OUT = args.out;
    const int gw = vcu * NWAVES + wave, NGW = G * NWAVES;
    const int gt = vcu * (NWAVES * 64) + tid, NGT = G * NWAVES * 64;

    if (IN(0)) for (int rep0 = 0; rep0 < ((REP_MASK & 1) ? 2 : 1); ++rep0) {
        if (rep0) xcd_barrier(bar);
        LAS float* scr = (LAS float*)(L + wave * 16384);
        const float* w_in = args.in[2]; const float* g1 = args.in[1]; const float* g2 = args.in[17];
        constexpr int I0 = 16 * 96, I1 = 16 * 16, I2 = 16 * 24, I3 = 16 * 64, I4 = 16 * 32, I5 = 8 * 32, I6 = 16 * 32, I7 = 16 * 88, I8 = 16 * 88, I9 = 44 * 32;
        constexpr int NITEMS = I0 + I1 + I2 + I3 + I4 + I5 + I6 + I7 + I8 + I9 + 256 + 256 + 8 + 8;
        for (int it = gw; it < ((rep0 && (REP_MASK & 0x2000)) ? 0 : NITEMS); it += NGW) {
            int r = it;
            if (r < I0) { tr_item<0>(w_in, IN_W, 0, 1024, Wt_in, 0, g1, scr, r / 96, r % 96, lane); continue; } r -= I0;
            if (r < I1) { tr_item<0>(w_in, IN_W, 3080, 1024, Wt_in, 3072, g1, scr, r / 16, r % 16, lane); continue; } r -= I1;
            if (r < I2) { tr_item<0>(w_in, IN_W, 3592, 1024, Wt_in, 3584, g1, scr, r / 24, r % 24, lane); continue; } r -= I2;
            if (r < I3) { tr_item<0>(w_in, IN_W, 4384, 1024, Wt_in, 4352, g1, scr, r / 64, r % 64, lane); continue; } r -= I3;
            if (r < I4) { tr_item<0>(args.in[14], 1024, 0, 1024, WaT, 0, nullptr, scr, r / 32, r % 32, lane); continue; } r -= I4;
            if (r < I5) { tr_item<0>(args.in[15], 1024, 0, 512, WbT, 0, nullptr, scr, r / 32, r % 32, lane); continue; } r -= I5;
            if (r < I6) { tr_item<0>(args.in[16], 1024, 0, 1024, WoT, 0, nullptr, scr, r / 32, r % 32, lane); continue; } r -= I6;
            if (r < I7) { tr_item<1>(args.in[18], FF, 0, 1024, WguT, 0, g2, scr, r / 88, r % 88, lane); continue; } r -= I7;
            if (r < I8) { tr_item<1>(args.in[19], FF, 0, 1024, WguT, 128, g2, scr, r / 88, r % 88, lane); continue; } r -= I8;
            if (r < I9) { tr_item<0>(args.in[20], 1024, 0, FF, WdT, 0, nullptr, scr, r / 32, r % 32, lane); continue; } r -= I9;
            if (r < 256) { tr_item<2>(args.in[9], 256, 0, 2048, (bf16*)(ws + WS_W1T), 256, nullptr, scr, r / 8, r % 8, lane); continue; } r -= 256;
            if (r < 256) { tr_item<2>(args.in[12], 256, 0, 2048, (bf16*)(ws + WS_W1T) + 256 * 2048, 256, nullptr, scr, r / 8, r % 8, lane); continue; } r -= 256;
            if (r < 8) { tr_item<0>(args.in[10], 64, 0, 256, (bf16*)(ws + WS_W2T), 0, nullptr, scr, r / 2, r % 2, lane); continue; } r -= 8;
            tr_item<0>(args.in[13], 64, 0, 256, (bf16*)(ws + WS_W2T) + 64 * 256, 0, nullptr, scr, r / 2, r % 2, lane);
        }
        if (vcu < 64 && rep0 == 0) { const int kind = tid >> 8, j = tid & 255; const float* pos = args.in[kind ? 11 : 8]; const float* w1 = args.in[kind ? 12 : 9]; float a = 0.f;
#pragma unroll 8
            for (int i = 32 * vcu; i < 32 * vcu + 32; ++i) a += pos[i] * w1[(size_t)i * 256 + j];
            atomicAdd((float*)(ws + WS_C1) + kind * 256 + j, a); }
        if (!rep0) for (int idx = gt; idx < 256 * 1024; idx += NGT) { const int r = idx >> 10, k = idx & 1023;
            float v = 0.f; if (r < 32) v = w_in[(size_t)k * IN_W + misc_src_col(r)] * g1[k];
            Wt_in[(size_t)(6400 + r) * 1024 + k] = (bf16)f2bf(v); }
        if (!rep0) for (int n = gt; n < NIN; n += NGT) biasp[n] = (n < IN_W) ? args.in[3][inproj_src_col(n)] : 0.f;
        {   const int mend = (rep0 && (REP_MASK & 0x1000)) ? 0 : TOK;
            int m0 = gw * 4; f32x4 v[4][4];
            if (m0 < mend) {
#pragma unroll
                for (int r = 0; r < 4; ++r) { const GAS f32x4* xr = (const GAS f32x4*)(x + (size_t)(m0 + r) * DM) + lane;
#pragma unroll
                    for (int j = 0; j < 4; ++j) v[r][j] = xr[64 * j]; } }
            while (m0 < mend) {
                const int m1 = m0 + NGW * 4; f32x4 vn[4][4];
#pragma unroll
                for (int r = 0; r < 4; ++r)
#pragma unroll
                    for (int j = 0; j < 4; ++j) vn[r][j] = v[r][j];
                if (m1 < mend) {
#pragma unroll
                    for (int r = 0; r < 4; ++r) { const GAS f32x4* xr = (const GAS f32x4*)(x + (size_t)(m1 + r) * DM) + lane;
#pragma unroll
                        for (int j = 0; j < 4; ++j) vn[r][j] = xr[64 * j]; } }
                float s[4];
#pragma unroll
                for (int r = 0; r < 4; ++r) { s[r] = 0.f;
#pragma unroll
                    for (int j = 0; j < 4; ++j) s[r] += (v[r][j].x * v[r][j].x + v[r][j].y * v[r][j].y) + (v[r][j].z * v[r][j].z + v[r][j].w * v[r][j].w); }
#pragma unroll
                for (int o = 1; o < 64; o <<= 1) {
#pragma unroll
                    for (int r = 0; r < 4; ++r) s[r] += __shfl_xor(s[r], o); }
#pragma unroll
                for (int r = 0; r < 4; ++r) { const float rs = 1.0f / sqrtf(s[r] * (1.f / DM) + RMS_EPS);
                    const int tt = (m0 + r) & 255, prow = ((m0 + r) & ~255) + ((tt >> 7) * 64 + ((tt >> 3) & 15) + ((tt >> 2) & 1) * 128 + (tt & 3) * 16);
                    GAS unsigned long long* o8 = (GAS unsigned long long*)(XN + (size_t)prow * DM) + lane;
#pragma unroll
                    for (int j = 0; j < 4; ++j) o8[64 * j] = (unsigned long long)pk2(v[r][j].x * rs, v[r][j].y * rs) | ((unsigned long long)pk2(v[r][j].z * rs, v[r][j].w * rs) << 32); }
                m0 = m1;
#pragma unroll
                for (int r = 0; r < 4; ++r)
#pragma unroll
                    for (int j = 0; j < 4; ++j) v[r][j] = vn[r][j];
            } }
        SEAM(0);
    }
    if (IN(1)) {
        pg8::Gemm g{XN, Wt_in, TOK, NIN, DM}; pg8::StaticOrder S; S.init(TOK, NIN, G, bx);
        for (int i = tid; i < NIN / 2; i += NWAVES * 64) ((LAS unsigned*)(L + 132096))[i] = pk2(biasp[2 * i], biasp[2 * i + 1]);
        __syncthreads();
        pg8::EpiInProj E{L + 132096, QM, KM, args.in[5], args.in[6], QKR, VM, OG, NQ, NKV, GA, GB, MISCB};
#ifndef P1_STAGGER
#define P1_STAGGER 0
#endif
        if (vcu & 1) { for (int k = 0; k < P1_STAGGER; ++k) __builtin_amdgcn_s_sleep(127); }
        pg8::gemm_phase<pg8::EpiInProj, pg8::StaticOrder, P1_ALIGN, true>(L, g, S, E);
#if REP_MASK & 2
        xcd_barrier(bar);
        if (REP_MASK & 0x400) { pg8::EpiNull EN; pg8::gemm_phase<pg8::EpiNull, pg8::StaticOrder, true, true>(L, g, S, EN); }
        else if (REP_MASK & 0x100) { pg8::EpiPlain EP{(bf16*)(ws + 48 * MiB), 1024}; pg8::gemm_phase<pg8::EpiPlain, pg8::StaticOrder, true, true>(L, g, S, EP); }
        else pg8::gemm_phase<pg8::EpiInProj, pg8::StaticOrder, true, true>(L, g, S, E);
#endif
        SEAM(1);
    }
    if (IN(2)) for (int rep2 = 0; rep2 < ((REP_MASK & 4) ? 2 : 1); ++rep2) {
        if (rep2) xcd_barrier(bar);
        const float* cw = args.in[5]; const float* cb = args.in[6];
        constexpr int NCMP = 64;
        const int gt2 = (vcu - NCMP) * (NWAVES * 64) + tid, NGT2 = (G - NCMP) * NWAVES * 64, gw2 = (vcu - NCMP) * NWAVES + wave, NGW2 = (G - NCMP) * NWAVES;
        for (int item = gt; item < 256 * 128; item += NGT) {
            const int blk = item >> 7, cg = item & 127, c0 = cg * 8, r0 = blk * 128, b = r0 >> 13, t0 = r0 & 8191;
            float w[4][8], bs[8], xr[6][8];
#pragma unroll
            for (int j = 0; j < 4; ++j)
#pragma unroll
                for (int i = 0; i < 8; ++i) w[j][i] = cw[j * 1024 + c0 + i];
#pragma unroll
            for (int i = 0; i < 8; ++i) bs[i] = cb[c0 + i];
#pragma unroll
            for (int k = 0; k < 6; ++k) { v4u a = {0u, 0u, 0u, 0u}; if (k >= 3 || t0 > 0) a = *(const GAS v4u*)(QKR + ((size_t)blk * 6 + k) * 1024 + c0);
                xr[k][0] = bfl(a.x); xr[k][1] = bfh(a.x); xr[k][2] = bfl(a.y); xr[k][3] = bfh(a.y); xr[k][4] = bfl(a.z); xr[k][5] = bfh(a.z); xr[k][6] = bfl(a.w); xr[k][7] = bfh(a.w); }
            const bool isk = c0 >= 512; const int cc = isk ? c0 - 512 : c0, h = cc >> 7, d = cc & 127;
            bf16* dst = (isk ? KM : QM) + ((size_t)((b * 4 + h) * 8192 + t0)) * 128 + d;
            const float osc = isk ? 0.08838834764831845f : 1.0f;
#pragma unroll
            for (int j = 0; j < 3; ++j) { float y[8];
#pragma unroll
                for (int i = 0; i < 8; ++i) { float v = bs[i] + w[0][i] * xr[j][i] + w[1][i] * xr[j + 1][i] + w[2][i] * xr[j + 2][i] + w[3][i] * xr[j + 3][i]; y[i] = v * sigm(v) * osc; }
                v4u o; o.x = pk2(y[0], y[1]); o.y = pk2(y[2], y[3]); o.z = pk2(y[4], y[5]); o.w = pk2(y[6], y[7]);
                *(GAS v4u*)(dst + (size_t)j * 128) = o; }
        }
        for (int ch0 = gt; ch0 < 8 * 128 * 8 * 64; ch0 += 4 * NGT) {
            v4u kq[4]; unsigned short e8[4][8];
#pragma unroll
            for (int q = 0; q < 4; ++q) { const int ch = (ch0 + q * NGT < 8 * 128 * 8 * 64) ? ch0 + q * NGT : ch0; const int ln = ch & 63, fr = (ch >> 6) & 7, blk = ch >> 9;
                const bf16* ks = NKV + (size_t)2 * pg8::NKV_KIND_ELEMS + (size_t)blk * 4096; const bf16* vs = NKV + (size_t)3 * pg8::NKV_KIND_ELEMS + (size_t)blk * 4096;
                const int i16 = ln & 15, fq4 = ln >> 4;
                { const int mt = fr >> 1, ks2 = fr & 1; kq[q] = *(const GAS v4u*)(ks + (16 * mt + i16) * 64 + 32 * ks2 + 8 * fq4); }
                { const int dt = fr >> 1, jj = fr & 1;
#pragma unroll
                  for (int e = 0; e < 8; ++e) e8[q][e] = vs[(32 * jj + 16 * (e >> 2) + 4 * fq4 + (e & 3)) * 64 + 16 * dt + i16]; } }
#pragma unroll
            for (int q = 0; q < 4; ++q) { const int ch = (ch0 + q * NGT < 8 * 128 * 8 * 64) ? ch0 + q * NGT : ch0; const int blk = ch >> 9;
                *(GAS v4u*)((bf16*)(ws + WS_KSF) + (size_t)ch * 8) = kq[q];
                v4u o; o.x = e8[q][0] | ((unsigned)e8[q][1] << 16); o.y = e8[q][2] | ((unsigned)e8[q][3] << 16); o.z = e8[q][4] | ((unsigned)e8[q][5] << 16); o.w = e8[q][6] | ((unsigned)e8[q][7] << 16);
                *(GAS v4u*)((bf16*)(ws + WS_VSF) + (size_t)ch * 8) = o;
                float vm = 0.f;
#pragma unroll
                for (int e = 0; e < 8; ++e) vm = fmaxf(vm, fabsf(bf2f(e8[q][e])));
                vm = wave_max(vm);
                if (lane == 0) { unsigned* vp = (unsigned*)(ws + WS_VMAX) + (blk >> 7); if (__float_as_uint(vm) > __hip_atomic_load(vp, RLX_AGENT)) atomicMax(vp, __float_as_uint(vm)); } } }
        for (int u = gw; u < 2048; u += NGW) mls::gate_chunk(args, u >> 7, u & 127, lane);
        for (int u = vcu; u < 256; u += G) cmpm::cmp_unit(args, L, u >> 7, (u >> 4) & 7, u & 15, tid);
#ifdef SELF_CHECK
        xcd_barrier(bar);
        { const int sub = tid >> 8, stid = tid & 255; LAS unsigned char* Ls = L + sub * 65536;
          for (int it = vcu * 2 + sub; it < 8192; it += 2 * G) cmp_item(args, Ls, it < 8176 ? it : 8175, stid, 45 * MiB, 45 * MiB + 512 * 1024); }
        xcd_barrier(bar);
        { float md = 0.f; const bf16* a = (const bf16*)(ws + WS_KCC); const bf16* r = (const bf16*)(ws + 45 * MiB);
          for (int i = gt; i < 2 * 8 * 512 * 64; i += NGT) { const int cc = (i >> 6) & 511; if (cc < 511) md = fmaxf(md, fabsf(bf2f(a[i]) - bf2f(r[i]))); }
          md = wave_max(md); if (lane == 0) atomicMax((unsigned*)(ctl + 24), __float_as_uint(md)); }
#endif
        SEAM(2);
    }
    if (IN(3)) {
#ifdef SELF_CHECK
        { const int sub = tid >> 8, stid = tid & 255; LAS unsigned char* Ls = L + sub * 65536; const int NS = 2 * G, niter = (65536 + NS - 1) / NS;
          for (int k = 0; k < niter; ++k) { const int it = k * NS + vcu * 2 + sub; nsa_scalar_item(args, Ls, it < 65536 ? it : 65535, stid, it < 65536, (bf16*)(ws + 144 * MiB)); } }
        xcd_barrier(bar);
#endif
        { const bool spread = false; const int sid = spread ? (((vcu & 31) < 4) ? (vcu >> 5) * 4 + (vcu & 31) : -1) : (vcu < 32 ? vcu : -1);
          if (sid >= 0) { mls::state_scan(args, L, sid >> 1, sid & 1, tid);
              asm volatile("s_waitcnt vmcnt(0)" ::: "memory"); __syncthreads();
              if (tid == 0) { __builtin_amdgcn_fence(__ATOMIC_RELEASE, "agent"); asm volatile("s_waitcnt vmcnt(0)" ::: "memory"); (void)xb_add((unsigned*)(ctl + 184), 1u); } } }
        { const unsigned myx = xb_xcc_id() & 7u;
          for (;;) {
            __syncthreads();
            if (tid == 0) { unsigned r = 0xFFFFFFFFu;
                for (unsigned k = 0; k < 8u; ++k) { const unsigned qx = (myx + k) & 7u; gu32* qc = ctl + 32 + 16 * qx;
                    if (__hip_atomic_load(qc, RLX_AGENT) >= 128u) continue;
                    const unsigned v = __hip_atomic_fetch_add(qc, 1u, RLX_AGENT);
                    if (v < 128u) { r = qx | ((127u - v) << 3); break; } }
                MISCW[16] = r; }
            __syncthreads();
            const unsigned r = MISCW[16];
            if (r == 0xFFFFFFFFu) break;
            nsa::nsa_unit(args, L, (int)(r & 7u), (int)(r >> 3), tid);
          } }
#ifndef MERGE34
#define MERGE34 1
#endif
        if (MERGE34 && IN(4)) {
            if (tid == 0) { XB_SPIN(xb_ld((unsigned*)(ctl + 184)) < 32u, (unsigned*)(ctl + CW_BAR)); __builtin_amdgcn_fence(__ATOMIC_ACQUIRE, "agent"); asm volatile("s_waitcnt vmcnt(0)" ::: "memory"); }
            __syncthreads();
            if (tid == 0) MISCW[16] = xb_add((unsigned*)(ctl + 168), 1u);
            __syncthreads();
            int u = (int)MISCW[16];
            if (u < 2048) { mls::OutPF pf; mls::out_prefetch(pf, args, u >> 7, u & 127, tid);
                for (;;) { __syncthreads(); if (tid == 0) MISCW[16] = xb_add((unsigned*)(ctl + 168), 1u); __syncthreads(); const int un = (int)MISCW[16];
                    mls::out_unit(args, L, u >> 7, u & 127, tid, pf, un < 2048, un >> 7, un & 127);
                    if (un >= 2048) break; u = un; } }
        }
#ifdef SELF_CHECK
        xcd_barrier(bar);
        { float md = 0.f; const bf16* r = (const bf16*)(ws + 144 * MiB);
          for (size_t i = gt; i < (size_t)TOK * 512; i += NGT) md = fmaxf(md, fabsf(bf2f(YB[i]) - bf2f(r[i])));
          md = wave_max(md); if (lane == 0) atomicMax((unsigned*)(ctl + 25), __float_as_uint(md)); }
#endif
#if REP_MASK & 8
        xcd_barrier(bar);
        if (vcu < 32) { if (REP_MASK & 0x10000) mls::state_scan(args, L, vcu >> 1, vcu & 1, tid); }
        else if (vcu >= 64) { if (REP_MASK & 0x20000) for (int u = vcu - 64; u < 1024; u += G - 64) nsa::nsa_unit(args, L, u & 7, 127 - (u >> 3), tid, (REP_MASK >> 20) & 511, 144 * MiB); }
#endif
        if (!(MERGE34 && IN(4))) SEAM(3);
    }
#if REP_MASK & 0x200
    xcd_barrier(bar); xcd_barrier(bar); xcd_barrier(bar); xcd_barrier(bar);
#endif
    if (IN(4)) {
        if (!(MERGE34 && IN(3)))
        { mls::OutPF pf; mls::out_prefetch(pf, args, vcu >> 7, vcu & 127, tid);
          for (int u = vcu; u < 2048; u += G) { const int un = u + G; mls::out_unit(args, L, u >> 7, u & 127, tid, pf, un < 2048, un >> 7, un & 127); } }
        SEAM(4);
    }
    if (IN(5)) {
        { pg8::Gemm g{YA, WaT, TOK, DM, DM}; pg8::StaticOrder S; S.init(TOK, DM, G, bx);
          pg8::EpiGateMul<false> E{GA, nullptr, T1};
          pg8::gemm_phase<pg8::EpiGateMul<false>, pg8::StaticOrder, true, true>(L, g, S, E); }
        asm volatile("s_waitcnt vmcnt(0)" ::: "memory"); __syncthreads();
        { pg8::Gemm g{YB, WbT, TOK, DM, 512}; pg8::StaticOrder S; S.init(TOK, DM, G, bx);
          pg8::EpiGateMul<true> E{GB, T1, MERGED};
          pg8::gemm_phase<pg8::EpiGateMul<true>, pg8::StaticOrder, true, true>(L, g, S, E); }
        SEAM(5);
    }
    if (IN(6)) {
        pg8::Gemm g{MERGED, WoT, TOK, DM, DM}; pg8::StaticOrder S; S.init(TOK, DM, G, bx);
        pg8::EpiResidual<true> E{x, X1B, ssq1};
        pg8::gemm_phase<pg8::EpiResidual<true>, pg8::StaticOrder, true, true>(L, g, S, E);
        SEAM(6);
    }
    if (IN(7)) {
        pg8::Gemm g{X1B, WguT, TOK, 2 * FF, DM}; pg8::StaticOrder S; S.init(TOK, 2 * FF, G, bx);
        pg8::EpiSwiGLU E{ssq1, ACT};
        pg8::gemm_phase<pg8::EpiSwiGLU, pg8::StaticOrder, true, true>(L, g, S, E);
#if REP_MASK & 128
        xcd_barrier(bar);
        if ((REP_MASK & 0xC000) == 0x4000) { pg8::EpiNull EN; pg8::gemm_phase<pg8::EpiNull, pg8::StaticOrder, true, true>(L, g, S, EN); }
        else if ((REP_MASK & 0xC000) == 0x8000) { pg8::EpiSwiGLUHot EH{ssq1, T1}; pg8::gemm_phase<pg8::EpiSwiGLUHot, pg8::StaticOrder, true, true>(L, g, S, EH); }
        else pg8::gemm_phase<pg8::EpiSwiGLU, pg8::StaticOrder, true, true>(L, g, S, E);
#endif
        SEAM(7);
    }
    if (IN(8)) {
        pg8::Gemm g{ACT, WdT, TOK, DM, FF}; pg8::StaticOrder S; S.init(TOK, DM, G, bx);
#ifndef FUSE_FNORM
#define FUSE_FNORM 1
#endif
#if FUSE_FNORM
        pg8::EpiResidNormF E{X1B, args.in[21], OUT, (float*)(ws + WS_KCC), (unsigned*)(ctl + 512), L + 132096};
        pg8::gemm_phase<pg8::EpiResidNormF, pg8::StaticOrder, true, true>(L, g, S, E);
#else
        pg8::EpiResidual<false> E{X1B, T1, ssq2};
        pg8::gemm_phase<pg8::EpiResidual<false>, pg8::StaticOrder, true, true>(L, g, S, E);
        SEAM(8);
#endif
    }
    if (IN(9) && !FUSE_FNORM) {
        const float* gf = args.in[21];
        for (int idx = gt; idx < TOK * 256; idx += NGT) { const int row = idx >> 8, c4 = idx & 255;
            const float r = 1.0f / sqrtf(ssq2[row] * (1.f / DM) + RMS_EPS);
            const unsigned long long xw = *((const GAS unsigned long long*)(T1 + (size_t)row * DM) + c4); const f32x4 gv = *((const GAS f32x4*)gf + c4);
            f32x4 v; v.x = bfl((unsigned)xw); v.y = bfh((unsigned)xw); v.z = bfl((unsigned)(xw >> 32)); v.w = bfh((unsigned)(xw >> 32));
            *((GAS f32x4*)(OUT + (size_t)row * DM) + c4) = v * r * gv; }
#ifdef SELF_CHECK
        if (gt == 0) { VM_WAIT(); OUT[0] += 1e3f * __uint_as_float(__hip_atomic_load(ctl + 24 + (SELF_CHECK), RLX_AGENT)); }
#endif
#ifdef DIAG_SEL
        if (gt == 0) { VM_WAIT(); const unsigned* dg = (const unsigned*)(ws + 768 * 1024); const float nn = (float)__hip_atomic_load((gu32*)dg + 3, RLX_AGENT);
            OUT[0] += 16.0f * (float)__hip_atomic_load((gu32*)dg + (DIAG_SEL), RLX_AGENT) / nn * 0.1f; }
#endif
    }
#undef IN
#undef SEAM
}

extern "C" void kernel_launch(void* const* d_in, const int* in_sizes, int n_in, void* d_out, int out_size, void* d_ws, size_t ws_size, hipStream_t stream) {
    static int grid = 0;
    if (grid == 0) {
        if (n_in != 22 || in_sizes[0] != TOK * DM || out_size != TOK * DM || ws_size < WS_END) {
            fprintf(stderr, "kernel_launch: unexpected shapes: n_in %d in0 %d out %d ws %zu\n", n_in, n_in > 0 ? in_sizes[0] : -1, out_size, ws_size); grid = -1; return; }
        int dev = 0, cus = 0;
        if (hipGetDevice(&dev) != hipSuccess || hipDeviceGetAttribute(&cus, hipDeviceAttributeMultiprocessorCount, dev) != hipSuccess) { grid = -1; return; }
        if (hipFuncSetAttribute((const void*)mk_fwd, hipFuncAttributeMaxDynamicSharedMemorySize, LDS_BYTES) != hipSuccess) { fprintf(stderr, "kernel_launch: hipFuncSetAttribute failed\n"); grid = -1; return; }
        int per_cu = 0;
        if (hipOccupancyMaxActiveBlocksPerMultiprocessor(&per_cu, (const void*)mk_fwd, NWAVES * 64, LDS_BYTES) != hipSuccess || per_cu < 1) fprintf(stderr, "kernel_launch: occupancy query says %d\n", per_cu);
        (void)hipGetLastError();
        grid = cus;
    }
    if (grid < 0) return;
    (void)hipMemsetAsync((char*)d_ws + WS_CTL, 0, CTL_ZERO_BYTES, stream);
    Args a{};
    for (int i = 0; i < 22; ++i) a.in[i] = (const float*)d_in[i];
    a.out = (float*)d_out; a.ws = (unsigned char*)d_ws;
    auto run = [&](int lo, int hi) { a.ph_lo = lo; a.ph_hi = hi; hipLaunchKernelGGL(mk_fwd, dim3(grid), dim3(NWAVES * 64), LDS_BYTES, stream, a); };
    run(0, 10);
}
```

```cpp
#include <hip/hip_runtime.h>
#include <cstdio>
#include <cstdint>
namespace pg8 {
#define PG8_LAS __attribute__((address_space(3)))
typedef unsigned short bf16_t;
typedef short bf16x8 __attribute__((ext_vector_type(8)));
typedef float f32x4 __attribute__((ext_vector_type(4)));
typedef unsigned u32x4 __attribute__((ext_vector_type(4)));
constexpr int BM = 256, BK = 64, HALF = 128, HTB = HALF * BK * 2  , STAGE_BYTES = 8 * HTB, NXCD = 8, WGM = 8;

__host__ __device__ __forceinline__ int lds_byte(int r, int c) { const int st = (r >> 4) * 2 + (c >> 5), rr = r & 15, cc = c & 31, ob = rr * 64 + cc * 2; return st * 1024 + (ob ^ (((ob >> 9) & 1) << 5)); }
__host__ __device__ __forceinline__ void stage_rc(int b, int& R, int& C) { const int st = b / 1024, sb = b % 1024, swz = sb ^ (((sb >> 9) & 1) << 5); R = (st >> 1) * 16 + swz / 64; C = (st & 1) * 32 + (swz % 64) / 2; }
__host__ __device__ __forceinline__ int perm32(int rho) { const int n = rho >> 4, i = rho & 15; return 8 * (i >> 2) + 4 * n + (i & 3); }

struct Unit { int pm, pn; };
struct Gemm { const bf16_t* A; const bf16_t* Bt; int M, N, K; };

struct StaticOrder {
    int nM, nN, nwg, G, c;
    __host__ __device__ void init(int M, int N, int G_, int c_) { nM = M / BM; nN = N / BM; nwg = nM * nN; G = G_; c = c_; }
    __host__ __device__ bool next(int i, Unit& u) const {
        const long L = (long)i * G + c; if (L >= nwg) return false;
        int wgid = (int)L; { const int q = nwg / NXCD, r = nwg % NXCD, xcd = wgid % NXCD, off = wgid / NXCD; wgid = (xcd < r ? xcd * (q + 1) : r * (q + 1) + (xcd - r) * q) + off; }
        const int nig = WGM * nN, gid = wgid / nig, fm = gid * WGM, gsz = (nM - fm) < WGM ? (nM - fm) : WGM;
        u.pm = fm + ((wgid % nig) % gsz); u.pn = (wgid % nig) / gsz; return true;
    }
    __device__ __forceinline__ void a_ready(const Unit&) const {}
    __device__ __forceinline__ void done(const Unit&) const {}
};

__device__ __forceinline__ unsigned cvt_pk_bf16(float lo, float hi) { unsigned r; asm volatile("v_cvt_pk_bf16_f32 %0, %1, %2" : "=v"(r) : "v"(lo), "v"(hi)); return r; }
typedef float f32x2 __attribute__((ext_vector_type(2)));
typedef unsigned u32x2 __attribute__((ext_vector_type(2)));
__device__ __forceinline__ float sigmoidf_(float v) { return __builtin_amdgcn_rcpf(1.0f + __builtin_amdgcn_exp2f(-1.4426950408889634f * v)); }
__device__ __forceinline__ float bf_lo(unsigned w) { return __builtin_bit_cast(float, w << 16); }
__device__ __forceinline__ float bf_hi(unsigned w) { return __builtin_bit_cast(float, w & 0xffff0000u); }
constexpr float QSCALE = 0.125f * 1.4426950408889634f;
constexpr int NKV_KIND_ELEMS = 4 * 2 * 8192 * 64;

__device__ __forceinline__ float dpp_row_shr1(float x) { return __builtin_bit_cast(float, __builtin_amdgcn_update_dpp(0, __builtin_bit_cast(int, x), 0x111, 0xF, 0xF, true)); }
struct EpiInProj {
    static constexpr bool PERM = true, AFTER_DRAIN = false;
    const PG8_LAS unsigned char* lbias; bf16_t* QM; bf16_t* KM; const float* cw; const float* cb; bf16_t* RAW6; bf16_t* V; bf16_t* OG; bf16_t* NQ; bf16_t* NKV; bf16_t* GA; bf16_t* GB; float* MISC;
    __device__ __forceinline__ void operator()(const f32x4 (&acc)[2][2][4][2], const Unit& u, int wr, int wc, int fr, int fq) const {
        const int pn = u.pn, tok0 = u.pm * BM + (wr * 16 + fr) * 8, ct = wc * 32 + 8 * fq;
        f32x4 bv[2][2];
#pragma unroll
        for (int bj = 0; bj < 2; ++bj) { const u32x4 bw = *(const PG8_LAS u32x4*)(lbias + (pn * BM + bj * HALF + ct) * 2);
            bv[bj][0] = (f32x4){bf_lo(bw.x), bf_hi(bw.x), bf_lo(bw.y), bf_hi(bw.y)}; bv[bj][1] = (f32x4){bf_lo(bw.z), bf_hi(bw.z), bf_lo(bw.w), bf_hi(bw.w)}; }
        if (pn < 4) {
            const int blk = u.pm * 2 + wr;
#pragma unroll
            for (int bj = 0; bj < 2; ++bj) {
                const int cq = pn * 256 + bj * HALF + ct;
                const bool isk = cq >= 512; const int cc = cq & 511, h = cc >> 7, d = cc & 127; const float osc = isk ? 0.08838834764831845f : 1.0f;
                f32x4 w[4][2], cbv[2];
#pragma unroll
                for (int k = 0; k < 4; ++k) { w[k][0] = *(const f32x4*)(cw + k * 1024 + cq); w[k][1] = *(const f32x4*)(cw + k * 1024 + cq + 4); }
                cbv[0] = *(const f32x4*)(cb + cq); cbv[1] = *(const f32x4*)(cb + cq + 4);
                f32x4 x3[2], x2[2], x1[2];
#pragma unroll
                for (int hf = 0; hf < 2; ++hf) { const f32x4 r5 = acc[1][bj][1][hf] + bv[bj][hf], r6 = acc[1][bj][2][hf] + bv[bj][hf], r7 = acc[1][bj][3][hf] + bv[bj][hf];
#pragma unroll
                    for (int i = 0; i < 4; ++i) { x3[hf][i] = dpp_row_shr1(r5[i]); x2[hf][i] = dpp_row_shr1(r6[i]); x1[hf][i] = dpp_row_shr1(r7[i]); } }
                bf16_t* dstb = (isk ? KM : QM) + ((size_t)(((tok0 >> 13) * 4 + h) * 8192 + (tok0 & 8191))) * 128 + d;
#pragma unroll
                for (int j = 0; j < 8; ++j) {
                    f32x4 xc[2], y[2];
#pragma unroll
                    for (int hf = 0; hf < 2; ++hf) { xc[hf] = acc[j >> 2][bj][j & 3][hf] + bv[bj][hf];
                        y[hf] = cbv[hf] + w[0][hf] * x3[hf] + w[1][hf] * x2[hf] + w[2][hf] * x1[hf] + w[3][hf] * xc[hf];
#pragma unroll
                        for (int i = 0; i < 4; ++i) y[hf][i] = y[hf][i] * sigmoidf_(y[hf][i]) * osc;
                        x3[hf] = x2[hf]; x2[hf] = x1[hf]; x1[hf] = xc[hf]; }
                    if (fr != 0 || j >= 3) { u32x4 o; o.x = cvt_pk_bf16(y[0][0], y[0][1]); o.y = cvt_pk_bf16(y[0][2], y[0][3]); o.z = cvt_pk_bf16(y[1][0], y[1][1]); o.w = cvt_pk_bf16(y[1][2], y[1][3]);
                        *(u32x4*)(dstb + (size_t)j * 128) = o; }
                    if ((fr == 0 && j < 3) || (fr == 15 && j >= 5)) { u32x4 o; o.x = cvt_pk_bf16(xc[0][0], xc[0][1]); o.y = cvt_pk_bf16(xc[0][2], xc[0][3]); o.z = cvt_pk_bf16(xc[1][0], xc[1][1]); o.w = cvt_pk_bf16(xc[1][2], xc[1][3]);
                        const int rr = (fr == 0) ? blk * 6 + 3 + j : (blk + 1) * 6 + (j - 5);
                        *(u32x4*)(RAW6 + (size_t)rr * 1024 + cq) = o; }
                }
            }
            return;
        }
        int mode = 0; bf16_t* base = V; int ldc = 1024, cbase = 0;
        if (pn < 8) { base = V; cbase = (pn - 4) * 256; }
        else if (pn < 12) { base = OG; cbase = (pn - 8) * 256; mode = 1; }
        else if (pn < 14) { base = NQ; ldc = 512; cbase = (pn - 12) * 256; mode = 2; }
        else if (pn < 17) { mode = 3; cbase = (pn - 14) * 256; }
        else if (pn < 21) { base = GA; cbase = (pn - 17) * 256; mode = 1; }
        else if (pn < 25) { base = GB; cbase = (pn - 21) * 256; mode = 1; }
        else { mode = 4; }
#pragma unroll
        for (int ai = 0; ai < 2; ++ai)
#pragma unroll
            for (int m = 0; m < 4; ++m) {
                const int row = tok0 + ai * 4 + m;
#pragma unroll
                for (int bj = 0; bj < 2; ++bj) {
                    f32x4 v0 = acc[ai][bj][m][0] + bv[bj][0], v1 = acc[ai][bj][m][1] + bv[bj][1];
                    const int c = cbase + bj * HALF + ct;
                    if (mode == 4) {
                        if (bj == 0 && ct < 32) { float* p = MISC + (size_t)row * 32 + ct; *(f32x4*)p = v0; *(f32x4*)(p + 4) = v1; }
                        continue;
                    }
                    if (mode == 1) {
#pragma unroll
                        for (int i = 0; i < 4; ++i) { v0[i] = sigmoidf_(v0[i]); v1[i] = sigmoidf_(v1[i]); }
                    } else if (mode == 2) { v0 = v0 * QSCALE; v1 = v1 * QSCALE; }
                    u32x4 w; w.x = cvt_pk_bf16(v0[0], v0[1]); w.y = cvt_pk_bf16(v0[2], v0[3]); w.z = cvt_pk_bf16(v1[0], v1[1]); w.w = cvt_pk_bf16(v1[2], v1[3]);
                    bf16_t* dst;
                    if (mode == 3) { const int kind = c >> 7, g = (c >> 6) & 1, d = c & 63, b = row >> 13, t = row & 8191;
                        dst = NKV + (size_t)kind * NKV_KIND_ELEMS + ((size_t)((b * 2 + g) * 8192 + t)) * 64 + d; }
                    else dst = base + (size_t)row * ldc + c;
                    *(u32x4*)dst = w;
                }
            }
    }
};
template <bool ADD> struct EpiGateMul {
    static constexpr bool PERM = true, AFTER_DRAIN = false;
    const bf16_t* gate; const bf16_t* prev; bf16_t* out;
    __device__ __forceinline__ void operator()(const f32x4 (&acc)[2][2][4][2], const Unit& u, int wr, int wc, int fr, int fq) const {
        const int row0 = u.pm * BM + wr * 64 + fr, col0 = u.pn * BM + wc * 32 + 8 * fq;
#pragma unroll
        for (int ai = 0; ai < 2; ++ai) {
            u32x4 gw[4][2], pw[ADD ? 4 : 1][2];
#pragma unroll
            for (int m = 0; m < 4; ++m)
#pragma unroll
                for (int bj = 0; bj < 2; ++bj) { const size_t off = (size_t)(row0 + ai * HALF + m * 16) * 1024 + col0 + bj * HALF;
                    gw[m][bj] = *(const u32x4*)(gate + off); if (ADD) pw[m][bj] = *(const u32x4*)(prev + off); }
#pragma unroll
            for (int m = 0; m < 4; ++m)
#pragma unroll
                for (int bj = 0; bj < 2; ++bj) { const size_t off = (size_t)(row0 + ai * HALF + m * 16) * 1024 + col0 + bj * HALF; const u32x4 g = gw[m][bj];
                    f32x4 v0 = acc[ai][bj][m][0], v1 = acc[ai][bj][m][1];
                    v0[0] *= bf_lo(g.x); v0[1] *= bf_hi(g.x); v0[2] *= bf_lo(g.y); v0[3] *= bf_hi(g.y);
                    v1[0] *= bf_lo(g.z); v1[1] *= bf_hi(g.z); v1[2] *= bf_lo(g.w); v1[3] *= bf_hi(g.w);
                    if (ADD) { const u32x4 q = pw[m][bj];
                        v0[0] += bf_lo(q.x); v0[1] += bf_hi(q.x); v0[2] += bf_lo(q.y); v0[3] += bf_hi(q.y);
                        v1[0] += bf_lo(q.z); v1[1] += bf_hi(q.z); v1[2] += bf_lo(q.w); v1[3] += bf_hi(q.w); }
                    u32x4 w; w.x = cvt_pk_bf16(v0[0], v0[1]); w.y = cvt_pk_bf16(v0[2], v0[3]); w.z = cvt_pk_bf16(v1[0], v1[1]); w.w = cvt_pk_bf16(v1[2], v1[3]);
                    *(u32x4*)(out + off) = w; }
        }
    }
};
template <bool XF32> struct EpiResidual {
    static constexpr bool PERM = false, AFTER_DRAIN = false;
    const void* xin; bf16_t* xb; float* ssq;
    __device__ __forceinline__ void operator()(const f32x4 (&acc)[2][2][4][2], const Unit& u, int wr, int wc, int fr, int fq) const {
        const int row0 = u.pm * BM + wr * 64 + fr, col0 = u.pn * BM + wc * 32 + 4 * fq;
#pragma unroll
        for (int ai = 0; ai < 2; ++ai) {
            f32x4 xv[1][4][2][2];
#pragma unroll
            for (int m = 0; m < 4; ++m)
#pragma unroll
                for (int bj = 0; bj < 2; ++bj)
#pragma unroll
                    for (int n = 0; n < 2; ++n) { const size_t o2 = (size_t)(row0 + ai * HALF + m * 16) * 1024 + col0 + bj * HALF + n * 16;
                        if (XF32) xv[0][m][bj][n] = *(const f32x4*)((const float*)xin + o2);
                        else { const u32x2 xw = *(const u32x2*)((const bf16_t*)xin + o2); xv[0][m][bj][n] = (f32x4){bf_lo(xw.x), bf_hi(xw.x), bf_lo(xw.y), bf_hi(xw.y)}; } }
#pragma unroll
            for (int m = 0; m < 4; ++m) {
                const int row = row0 + ai * HALF + m * 16; const size_t off = (size_t)row * 1024 + col0; float s = 0.f;
#pragma unroll
                for (int bj = 0; bj < 2; ++bj)
#pragma unroll
                    for (int n = 0; n < 2; ++n) {
                        const size_t o2 = off + bj * HALF + n * 16;
                        f32x4 v = xv[0][m][bj][n];
                        v = v + acc[ai][bj][m][n];
                        s += (v[0] * v[0] + v[1] * v[1]) + (v[2] * v[2] + v[3] * v[3]);
                        u32x2 w; w.x = cvt_pk_bf16(v[0], v[1]); w.y = cvt_pk_bf16(v[2], v[3]); *(u32x2*)(xb + o2) = w;
                    }
                s += __shfl_xor(s, 16); s += __shfl_xor(s, 32);
                if (fq == 0) atomicAdd(ssq + row, s);
            }
        }
    }
};
struct EpiResidNormF {
    static constexpr bool PERM = false, AFTER_DRAIN = false;
    const bf16_t* xin; const float* gf; float* out; float* slots; unsigned* cnt; PG8_LAS unsigned char* lscr;
    __device__ __forceinline__ void operator()(const f32x4 (&acc_)[2][2][4][2], const Unit& u, int wr, int wc, int fr, int fq) const {
        f32x4 (&acc)[2][2][4][2] = const_cast<f32x4 (&)[2][2][4][2]>(acc_);
        const int rl0 = wr * 64 + fr, row0 = u.pm * BM + rl0, col0 = u.pn * BM + wc * 32 + 4 * fq, tid = threadIdx.x;
        PG8_LAS float* part = (PG8_LAS float*)lscr; PG8_LAS float* rsl = part + 1024;
#pragma unroll
        for (int ai = 0; ai < 2; ++ai)
#pragma unroll
            for (int m = 0; m < 4; ++m) {
                const size_t off = (size_t)(row0 + ai * HALF + m * 16) * 1024 + col0; float s = 0.f;
#pragma unroll
                for (int bj = 0; bj < 2; ++bj)
#pragma unroll
                    for (int n = 0; n < 2; ++n) {
                        const u32x2 xw = *(const u32x2*)(xin + off + bj * HALF + n * 16);
                        f32x4 v; v[0] = bf_lo(xw.x); v[1] = bf_hi(xw.x); v[2] = bf_lo(xw.y); v[3] = bf_hi(xw.y);
                        v = v + acc[ai][bj][m][n]; acc[ai][bj][m][n] = v;
                        s += (v[0] * v[0] + v[1] * v[1]) + (v[2] * v[2] + v[3] * v[3]); }
                s += __shfl_xor(s, 16); s += __shfl_xor(s, 32);
                if (fq == 0) part[wc * 256 + rl0 + ai * HALF + m * 16] = s; }
        asm volatile("s_waitcnt lgkmcnt(0)" ::: "memory"); __builtin_amdgcn_s_barrier(); asm volatile("" ::: "memory");
        if (tid < 256) slots[((size_t)u.pm * 4 + u.pn) * 256 + tid] = (part[tid] + part[256 + tid]) + (part[512 + tid] + part[768 + tid]);
        asm volatile("s_waitcnt vmcnt(0)" ::: "memory"); __builtin_amdgcn_s_barrier(); asm volatile("" ::: "memory");
        if (tid == 0) {
            __builtin_amdgcn_fence(__ATOMIC_RELEASE, "agent"); asm volatile("s_waitcnt vmcnt(0)" ::: "memory");
            (void)__hip_atomic_fetch_add(cnt + u.pm, 1u, __ATOMIC_RELAXED, __HIP_MEMORY_SCOPE_AGENT);
            unsigned sp = 0u; while (__hip_atomic_load(cnt + u.pm, __ATOMIC_RELAXED, __HIP_MEMORY_SCOPE_AGENT) < 4u) { __builtin_amdgcn_s_sleep(1); if (++sp > (1u << 22)) break; }
            __builtin_amdgcn_fence(__ATOMIC_ACQUIRE, "agent"); asm volatile("s_waitcnt vmcnt(0)" ::: "memory"); }
        __builtin_amdgcn_s_barrier(); asm volatile("" ::: "memory");
        if (tid < 256) { const unsigned* sp4 = (const unsigned*)(slots + (size_t)u.pm * 1024 + tid);
            const float t = (__uint_as_float(__hip_atomic_load(sp4, __ATOMIC_RELAXED, __HIP_MEMORY_SCOPE_AGENT)) + __uint_as_float(__hip_atomic_load(sp4 + 256, __ATOMIC_RELAXED, __HIP_MEMORY_SCOPE_AGENT)))
                          + (__uint_as_float(__hip_atomic_load(sp4 + 512, __ATOMIC_RELAXED, __HIP_MEMORY_SCOPE_AGENT)) + __uint_as_float(__hip_atomic_load(sp4 + 768, __ATOMIC_RELAXED, __HIP_MEMORY_SCOPE_AGENT)));
            rsl[tid] = 1.0f / sqrtf(t * (1.0f / 1024.0f) + 1e-6f); }
        asm volatile("s_waitcnt lgkmcnt(0)" ::: "memory"); __builtin_amdgcn_s_barrier(); asm volatile("" ::: "memory");
        f32x4 gv[2][2];
#pragma unroll
        for (int bj = 0; bj < 2; ++bj)
#pragma unroll
            for (int n = 0; n < 2; ++n) gv[bj][n] = *(const f32x4*)(gf + col0 + bj * HALF + n * 16);
#pragma unroll
        for (int ai = 0; ai < 2; ++ai)
#pragma unroll
            for (int m = 0; m < 4; ++m) { const int rl = rl0 + ai * HALF + m * 16; const float r = rsl[rl]; const size_t off = (size_t)(u.pm * BM + rl) * 1024 + col0;
#pragma unroll
                for (int bj = 0; bj < 2; ++bj)
#pragma unroll
                    for (int n = 0; n < 2; ++n) *(f32x4*)(out + off + bj * HALF + n * 16) = acc[ai][bj][m][n] * r * gv[bj][n]; }
    }
};
struct EpiSwiGLU {
    static constexpr bool PERM = true, AFTER_DRAIN = false;
    const float* ssq; bf16_t* act;
    __device__ __forceinline__ void operator()(const f32x4 (&acc)[2][2][4][2], const Unit& u, int wr, int wc, int fr, int fq) const {
        const int row0 = u.pm * BM + wr * 64 + fr, col0 = u.pn * HALF + wc * 32 + 8 * fq;
        float sq[2][4];
#pragma unroll
        for (int ai = 0; ai < 2; ++ai)
#pragma unroll
            for (int m = 0; m < 4; ++m) sq[ai][m] = ssq[row0 + ai * HALF + m * 16];
#pragma unroll
        for (int ai = 0; ai < 2; ++ai)
#pragma unroll
            for (int m = 0; m < 4; ++m) {
                const int row = row0 + ai * HALF + m * 16;
                const float r = __builtin_amdgcn_rsqf(sq[ai][m] * (1.0f / 1024.0f) + 1e-6f);
                float o[8];
#pragma unroll
                for (int n = 0; n < 2; ++n)
#pragma unroll
                    for (int i = 0; i < 4; ++i) { const float g = acc[ai][0][m][n][i] * r, up = acc[ai][1][m][n][i] * r; o[n * 4 + i] = g * sigmoidf_(g) * up; }
                u32x4 w; w.x = cvt_pk_bf16(o[0], o[1]); w.y = cvt_pk_bf16(o[2], o[3]); w.z = cvt_pk_bf16(o[4], o[5]); w.w = cvt_pk_bf16(o[6], o[7]);
                *(u32x4*)(act + (size_t)row * 2816 + col0) = w;
            }
    }
};

struct EpiPlain {
    static constexpr bool PERM = true, AFTER_DRAIN = false;
    bf16_t* out; int ldc;
    __device__ __forceinline__ void operator()(const f32x4 (&acc)[2][2][4][2], const Unit& u, int wr, int wc, int fr, int fq) const {
        const int row0 = u.pm * BM + wr * 64 + fr, col0 = (u.pn & 3) * BM + wc * 32 + 8 * fq;
#pragma unroll
        for (int ai = 0; ai < 2; ++ai)
#pragma unroll
            for (int m = 0; m < 4; ++m) { bf16_t* rowp = out + (size_t)(row0 + ai * HALF + m * 16) * ldc + col0;
#pragma unroll
                for (int bj = 0; bj < 2; ++bj) { const f32x4 v0 = acc[ai][bj][m][0], v1 = acc[ai][bj][m][1];
                    u32x4 w; w.x = cvt_pk_bf16(v0[0], v0[1]); w.y = cvt_pk_bf16(v0[2], v0[3]); w.z = cvt_pk_bf16(v1[0], v1[1]); w.w = cvt_pk_bf16(v1[2], v1[3]);
                    *(u32x4*)(rowp + bj * HALF) = w; } }
    }
};
template <class Epi, class Sched, bool ALIGN_EPI = false, bool SP2 = false>
__device__ __forceinline__ void gemm_phase(PG8_LAS unsigned char* lds, const Gemm g, const Sched& S, const Epi& E) {
    const int tid = threadIdx.x, wid = __builtin_amdgcn_readfirstlane(tid >> 6), lane = tid & 63, wr = wid >> 2, wc = wid & 3, fr = lane & 15, fq = lane >> 4;
    const int K = g.K, nt = K / BK;
    unsigned voffA[2], voffB[2];
#pragma unroll
    for (int i = 0; i < 2; ++i) { int R, C; stage_rc(tid * 16 + i * 8192, R, C); const int Rb = Epi::PERM ? ((R & ~31) + perm32(R & 31)) : R;
        voffA[i] = (unsigned)(R * K + C) * 2u; voffB[i] = (unsigned)(Rb * K + C) * 2u; }
    const size_t kstep = (size_t)(BK * 2);
    const size_t hstep = (size_t)HALF * K * 2;
    const size_t tstep = 2 * hstep;
    const unsigned ldsw = (unsigned)wid * 1024u;
    const int aoff = lds_byte(wr * 64 + fr, fq * 8), boff = lds_byte(wc * 32 + fr, fq * 8);
#define PG8_SA(b, h) (((b) * 2 + (h)) * HTB)
#define PG8_SB(b, h) ((4 + (b) * 2 + (h)) * HTB)
#define PG8_STAGE(bufoff, gbase, voff) do { _Pragma("unroll") for (int _i = 0; _i < 2; ++_i) \
        __builtin_amdgcn_global_load_lds((const unsigned*)((const char*)(gbase) + (voff)[_i]), (PG8_LAS unsigned*)(lds + (bufoff) + ldsw + _i * 8192), 16, 0, 0); } while (0)
#define PG8_LDA(dst, b, h) do { _Pragma("unroll") for (int m = 0; m < 4; ++m) _Pragma("unroll") for (int k = 0; k < 2; ++k) dst[m][k] = *(const PG8_LAS bf16x8*)(lds + PG8_SA(b, h) + aoff + m * 2048 + k * 1024); } while (0)
#define PG8_LDB(dst, b, h) do { _Pragma("unroll") for (int n = 0; n < 2; ++n) _Pragma("unroll") for (int k = 0; k < 2; ++k) dst[n][k] = *(const PG8_LAS bf16x8*)(lds + PG8_SB(b, h) + boff + n * 2048 + k * 1024); } while (0)
#define PG8_MMA(ai, bj, At, Bt) do { __builtin_amdgcn_s_setprio(1); _Pragma("unroll") for (int m = 0; m < 4; ++m) _Pragma("unroll") for (int n = 0; n < 2; ++n) _Pragma("unroll") for (int k = 0; k < 2; ++k) \
        acc[ai][bj][m][n] = __builtin_amdgcn_mfma_f32_16x16x32_bf16(Bt[n][k], At[m][k], acc[ai][bj][m][n], 0, 0, 0); __builtin_amdgcn_s_setprio(0); } while (0)
#define PG8_WAIT_V(n) asm volatile("s_waitcnt vmcnt(" #n ")" ::: "memory")
#define PG8_WAIT_L(n) asm volatile("s_waitcnt lgkmcnt(" #n ")" ::: "memory")
#define PG8_BAR __builtin_amdgcn_s_barrier()
#define PG8_SCHED __builtin_amdgcn_sched_barrier(0)
    Unit cur, nxt; int ui = 0;
    if (!S.next(0, cur)) return;
    f32x4 acc[2][2][4][2];
#pragma unroll
    for (int a = 0; a < 2; ++a)
#pragma unroll
        for (int b = 0; b < 2; ++b)
#pragma unroll
            for (int m = 0; m < 4; ++m)
#pragma unroll
                for (int n = 0; n < 2; ++n) acc[a][b][m][n] = (f32x4){0.f, 0.f, 0.f, 0.f};
    bf16x8 At[4][2], B0[2][2], B1[2][2];
    const char* cA = (const char*)g.A + (size_t)cur.pm * tstep; const char* cB = (const char*)g.Bt + (size_t)cur.pn * tstep;
    S.a_ready(cur);
    if constexpr (SP2) {
        PG8_STAGE(PG8_SB(0, 0), cB, voffB); PG8_STAGE(PG8_SB(0, 1), cB + hstep, voffB); PG8_STAGE(PG8_SA(0, 0), cA, voffA); PG8_STAGE(PG8_SA(0, 1), cA + hstep, voffA);
        if (wr == 1) PG8_BAR;
        PG8_WAIT_V(2); PG8_BAR;
        PG8_STAGE(PG8_SB(1, 0), cB + kstep, voffB); PG8_STAGE(PG8_SA(1, 0), cA + kstep, voffA); PG8_STAGE(PG8_SB(1, 1), cB + hstep + kstep, voffB);
        PG8_WAIT_V(6); PG8_BAR;
    } else {
        PG8_STAGE(PG8_SB(0, 0), cB, voffB); PG8_STAGE(PG8_SA(0, 0), cA, voffA); PG8_STAGE(PG8_SB(0, 1), cB + hstep, voffB); PG8_STAGE(PG8_SA(0, 1), cA + hstep, voffA);
        if (wr == 1) PG8_BAR;
        PG8_WAIT_V(4); PG8_BAR;
        PG8_STAGE(PG8_SB(1, 0), cB + kstep, voffB); PG8_STAGE(PG8_SA(1, 0), cA + kstep, voffA); PG8_STAGE(PG8_SB(1, 1), cB + hstep + kstep, voffB);
        PG8_WAIT_V(6); PG8_BAR;
    }
    for (;;) {
        const bool has_next = S.next(ui + 1, nxt);
        const char* nA = has_next ? (const char*)g.A + (size_t)nxt.pm * tstep : cA; const char* nB = has_next ? (const char*)g.Bt + (size_t)nxt.pn * tstep : cB;
        for (int t = 0; t < nt; t += 2) {
            const bool last = (t == nt - 2);
            const char* a1 = cA + (size_t)(t + 1) * kstep;
            const char* a2 = last ? nA : cA + (size_t)(t + 2) * kstep; const char* b2 = last ? nB : cB + (size_t)(t + 2) * kstep;
            const char* a3 = a2 + kstep; const char* b3 = b2 + kstep;
            if (last && has_next) S.a_ready(nxt);
            if constexpr (SP2) {
            PG8_LDB(B0, 0, 0); PG8_LDB(B1, 0, 1); PG8_SCHED; PG8_LDA(At, 0, 0); PG8_STAGE(PG8_SA(1, 1), a1 + hstep, voffA);
            PG8_WAIT_V(8); PG8_WAIT_L(0); PG8_BAR; PG8_MMA(0, 0, At, B0); PG8_MMA(0, 1, At, B1); PG8_BAR; PG8_SCHED;
            PG8_LDA(At, 0, 1); PG8_STAGE(PG8_SB(0, 0), b2, voffB); PG8_STAGE(PG8_SB(0, 1), b2 + hstep, voffB); PG8_STAGE(PG8_SA(0, 0), a2, voffA);
            PG8_WAIT_V(8); PG8_WAIT_L(0); PG8_BAR; PG8_MMA(1, 0, At, B0); PG8_MMA(1, 1, At, B1); PG8_BAR; PG8_SCHED;
            PG8_LDB(B0, 1, 0); PG8_LDB(B1, 1, 1); PG8_SCHED; PG8_LDA(At, 1, 0); PG8_STAGE(PG8_SA(0, 1), a2 + hstep, voffA);
            PG8_WAIT_V(8); PG8_WAIT_L(0); PG8_BAR; PG8_MMA(0, 0, At, B0); PG8_MMA(0, 1, At, B1); PG8_BAR; PG8_SCHED;
            PG8_LDA(At, 1, 1); PG8_STAGE(PG8_SB(1, 0), b3, voffB); PG8_STAGE(PG8_SB(1, 1), b3 + hstep, voffB); PG8_STAGE(PG8_SA(1, 0), a3, voffA);
            PG8_WAIT_V(8); PG8_WAIT_L(0); PG8_BAR; PG8_MMA(1, 0, At, B0); PG8_MMA(1, 1, At, B1); PG8_BAR; PG8_SCHED;
            } else {
            PG8_LDB(B0, 0, 0); PG8_SCHED; PG8_LDA(At, 0, 0); PG8_STAGE(PG8_SA(1, 1), a1 + hstep, voffA);
            PG8_WAIT_L(8); PG8_BAR; PG8_WAIT_L(0); PG8_MMA(0, 0, At, B0); PG8_BAR; PG8_SCHED;
            PG8_LDB(B1, 0, 1); PG8_STAGE(PG8_SB(0, 0), b2, voffB);
            PG8_BAR; PG8_WAIT_L(0); PG8_MMA(0, 1, At, B1); PG8_BAR;
            PG8_LDA(At, 0, 1); PG8_STAGE(PG8_SA(0, 0), a2, voffA);
            PG8_BAR; PG8_WAIT_L(0); PG8_MMA(1, 0, At, B0); PG8_BAR; PG8_SCHED;
            PG8_STAGE(PG8_SB(0, 1), b2 + hstep, voffB);
            PG8_WAIT_V(6); PG8_BAR; PG8_MMA(1, 1, At, B1); PG8_BAR;
            PG8_LDB(B0, 1, 0); PG8_SCHED; PG8_LDA(At, 1, 0); PG8_STAGE(PG8_SA(0, 1), a2 + hstep, voffA);
            PG8_WAIT_L(8); PG8_BAR; PG8_WAIT_L(0); PG8_MMA(0, 0, At, B0); PG8_BAR; PG8_SCHED;
            PG8_LDB(B1, 1, 1); PG8_STAGE(PG8_SB(1, 0), b3, voffB);
            PG8_BAR; PG8_WAIT_L(0); PG8_MMA(0, 1, At, B1); PG8_BAR;
            PG8_LDA(At, 1, 1); PG8_STAGE(PG8_SA(1, 0), a3, voffA);
            PG8_BAR; PG8_WAIT_L(0); PG8_MMA(1, 0, At, B0); PG8_BAR; PG8_SCHED;
            PG8_STAGE(PG8_SB(1, 1), b3 + hstep, voffB);
            PG8_WAIT_V(6); PG8_BAR; PG8_MMA(1, 1, At, B1); PG8_BAR;
            }
        }
        if constexpr (ALIGN_EPI) { if (wr == 0) PG8_BAR; }
        if constexpr (!Epi::AFTER_DRAIN) { E(acc, cur, wr, wc, fr, fq); S.done(cur); }
        if (!has_next) break;
#pragma unroll
        for (int a = 0; a < 2; ++a)
#pragma unroll
            for (int b = 0; b < 2; ++b)
#pragma unroll
                for (int m = 0; m < 4; ++m)
#pragma unroll
                    for (int n = 0; n < 2; ++n) acc[a][b][m][n] = (f32x4){0.f, 0.f, 0.f, 0.f};
        cur = nxt; cA = nA; cB = nB; ++ui;
        if constexpr (ALIGN_EPI) { if (wr == 1) PG8_BAR; }
    }
    PG8_WAIT_V(0);
    if constexpr (!ALIGN_EPI) { if (wr == 0) PG8_BAR; }
    PG8_BAR;
    if constexpr (Epi::AFTER_DRAIN) { E.fused(acc, cur, wr, wc, fr, fq, lds, wid, lane); S.done(cur); }
#undef PG8_SA
#undef PG8_SB
#undef PG8_STAGE
#undef PG8_LDA
#undef PG8_LDB
#undef PG8_MMA
#undef PG8_WAIT_V
#undef PG8_WAIT_L
#undef PG8_BAR
#undef PG8_SCHED
}
}
#define GAS __attribute__((address_space(1)))
#define LAS __attribute__((address_space(3)))
typedef unsigned short bf16;
typedef unsigned v4u __attribute__((ext_vector_type(4)));
typedef float f32x4 __attribute__((ext_vector_type(4)));
typedef short bf16x8 __attribute__((ext_vector_type(8)));
typedef GAS unsigned gu32;
typedef GAS unsigned long long gu64;
#define RLX_AGENT __ATOMIC_RELAXED, __HIP_MEMORY_SCOPE_AGENT
#define LDS_WAIT() asm volatile("s_waitcnt lgkmcnt(0)" ::: "memory")
#define VM_WAIT() asm volatile("s_waitcnt vmcnt(0)" ::: "memory")
__device__ __forceinline__ unsigned long long rt() { return __builtin_amdgcn_s_memrealtime(); }
__device__ __forceinline__ unsigned f2bf(float f) { unsigned u = __builtin_bit_cast(unsigned, f); return (u + 0x7fffu + ((u >> 16) & 1u)) >> 16; }
__device__ __forceinline__ unsigned pk2(float lo, float hi) { return f2bf(lo) | (f2bf(hi) << 16); }

#define XB_TMO      128
#define XB_XCNT(j)  (256  + 64 * (j))
#define XB_XSUB(j)  (1280 + 64 * (j))
#define XB_XGEN(j)  (2304 + 64 * (j))
#define XB_TOP      3328
#define XB_TOPGEN   3392
#define XCD_BAR_WORDS 3456
#define XB_SPIN_CAP (1u << 18)

__device__ __forceinline__ unsigned xb_ld(unsigned* p)              { return __hip_atomic_load(p, __ATOMIC_RELAXED, __HIP_MEMORY_SCOPE_AGENT); }
__device__ __forceinline__ unsigned xb_add(unsigned* p, unsigned v) { return __hip_atomic_fetch_add(p, v, __ATOMIC_RELAXED, __HIP_MEMORY_SCOPE_AGENT); }
__device__ __forceinline__ unsigned xb_xcc_id() { return (unsigned)__builtin_amdgcn_s_getreg((3 << 11) | 20) & 0xFu; }
#define XB_SPIN(cond, bar) do { unsigned _sp = 0; while (cond) { __builtin_amdgcn_s_sleep(1); \
    if ((++_sp & 255u) == 0u) { if (xb_ld(&(bar)[XB_TMO])) break; if (_sp > XB_SPIN_CAP) { atomicAdd(&(bar)[XB_TMO], 1u); break; } } } } while (0)

struct XcdBarrier {
    unsigned* bar; unsigned x;
    volatile LAS unsigned* st;
};

__device__ __forceinline__ XcdBarrier xcd_barrier_post(unsigned* bar, volatile LAS unsigned* st) {
    XcdBarrier b; b.bar = bar; b.x = xb_xcc_id(); b.st = st;
    if (threadIdx.x == 0) (void)xb_add(&bar[XB_XCNT(b.x)], 1u);
    return b;
}
__device__ __forceinline__ void xcd_barrier_complete(unsigned* bar, unsigned x, unsigned& nloc, unsigned& nx) {
    const unsigned G = gridDim.x * gridDim.y * gridDim.z;
    unsigned sum, cnt, mine, sp = 0u;
    for (;;) {
        sum = 0u; cnt = 0u; mine = 0u;
#pragma unroll
        for (unsigned j = 0; j < 16; ++j) { const unsigned c = xb_ld(&bar[XB_XCNT(j)]); sum += c; cnt += (c > 0u) ? 1u : 0u; mine = (j == x) ? c : mine; }
        if (sum == G) break;
        __builtin_amdgcn_s_sleep(1);
        if ((++sp & 255u) == 0u) { if (xb_ld(&bar[XB_TMO])) break; if (sp > XB_SPIN_CAP) { atomicAdd(&bar[XB_TMO], 1u); break; } }
    }
    nloc = mine > 0u ? mine : 1u; nx = cnt > 0u ? cnt : 1u;
}

__device__ __forceinline__ void xcd_barrier(const XcdBarrier& b) {
    asm volatile("s_waitcnt vmcnt(0)" ::: "memory");
    __syncthreads();
    if (threadIdx.x == 0) {
        unsigned* bar = b.bar;
        __builtin_amdgcn_s_waitcnt(0);
        unsigned nloc = b.st[0], nx = b.st[1];
        if (nloc == 0u) { xcd_barrier_complete(bar, b.x, nloc, nx); b.st[0] = nloc; b.st[1] = nx; }
        const unsigned old = xb_add(&bar[XB_XSUB(b.x)], 1u);
        const unsigned gen = old / nloc;
        if (old + 1u == (gen + 1u) * nloc) {
            __builtin_amdgcn_fence(__ATOMIC_RELEASE, "agent");
            asm volatile("s_waitcnt vmcnt(0)" ::: "memory");
            const unsigned og = xb_add(&bar[XB_TOP], 1u);
            const unsigned tg = og / nx;
            if (og + 1u == (tg + 1u) * nx) xb_add(&bar[XB_TOPGEN], 1u);
            else XB_SPIN(xb_ld(&bar[XB_TOPGEN]) == tg, bar);
            __builtin_amdgcn_fence(__ATOMIC_ACQUIRE, "agent");
            xb_add(&bar[XB_XGEN(b.x)], 1u);
            asm volatile("s_waitcnt vmcnt(0)" ::: "memory");
        } else {
            XB_SPIN(xb_ld(&bar[XB_XGEN(b.x)]) == gen, bar);
            __builtin_amdgcn_fence(__ATOMIC_ACQUIRE, "agent");
            asm volatile("s_waitcnt vmcnt(0)" ::: "memory");
        }
    }
    __syncthreads();
}

constexpr int BATCH = 4, SEQ = 8192, DM = 1024, TOK = BATCH * SEQ;
constexpr int IN_W = 6432, NIN = 6656, FF = 2816;
constexpr float RMS_EPS = 1e-6f;
constexpr int NWAVES = 8;
constexpr size_t MiB = 1u << 20;
constexpr size_t WS_CTL = 0, CTL_ZERO_BYTES = 1 * MiB;
constexpr int CW_BAR = 4096;
constexpr size_t WS_SSQ1 = 256 * 1024, WS_SSQ2 = 384 * 1024;
constexpr size_t WS_KSF = 48 * MiB, WS_VSF = 56 * MiB, WS_PARK = 64 * MiB;
constexpr size_t WS_VMAX = 768 * 1024;
constexpr size_t WS_BIASP = 1 * MiB;
constexpr size_t WS_WIN = 2 * MiB, WS_WA = 15 * MiB, WS_WB = 17 * MiB, WS_WO = 18 * MiB, WS_WGU = 20 * MiB, WS_WD = 31 * MiB;
constexpr size_t WS_MISC = 40 * MiB;
constexpr size_t WS_KCC = 44 * MiB, WS_VCC = 44 * MiB + 512 * 1024;
constexpr size_t WS_XN = 48 * MiB;
constexpr size_t WS_QM = 112 * MiB, WS_KM = 144 * MiB;
constexpr size_t WS_T1 = 112 * MiB;
constexpr size_t WS_QKR = 112 * MiB, WS_YB = 80 * MiB;
constexpr size_t WS_VM = 176 * MiB, WS_YA = 176 * MiB;
constexpr size_t WS_OG = 240 * MiB, WS_X1B = 240 * MiB;
constexpr size_t WS_NQ = 304 * MiB;
constexpr size_t WS_NKV = 336 * MiB;
constexpr size_t WS_GA = 384 * MiB, WS_GB = 448 * MiB, WS_MERGED = 384 * MiB;
constexpr size_t WS_ACT = 304 * MiB;
constexpr size_t WS_END = 512 * MiB;
constexpr int RING_BYTES = 131072, LDSCTL_OFF = RING_BYTES, MISC_OFF = LDSCTL_OFF + 320, LDS_BYTES = 147456;

__device__ __forceinline__ float bfl(unsigned w) { return __builtin_bit_cast(float, w << 16); }
__device__ __forceinline__ float bfh(unsigned w) { return __builtin_bit_cast(float, w & 0xffff0000u); }
__device__ __forceinline__ float bf2f(bf16 h) { return __builtin_bit_cast(float, (unsigned)h << 16); }
__device__ __forceinline__ float sigm(float v) { return 1.0f / (1.0f + __expf(-v)); }
__device__ __forceinline__ float wave_sum(float v) {
#pragma unroll
    for (int o = 1; o < 64; o <<= 1) v += __shfl_xor(v, o);
    return v;
}
__device__ __forceinline__ float wave_max(float v) {
#pragma unroll
    for (int o = 1; o < 64; o <<= 1) v = fmaxf(v, __shfl_xor(v, o));
    return v;
}

template <int MODE>
__device__ __forceinline__ void tr_item(const float* W, int ldw, int src_col0, int K, bf16* WT, int dst_row0, const float* rscale, LAS float* scr, int kb, int nb, int lane) {
    const int k0 = 64 * kb, n0 = 32 * nb;
    {
        f32x4 v[8]; float rs[8];
#pragma unroll
        for (int i = 0; i < 8; ++i) { const int kk = 8 * i + (lane >> 3); v[i] = *(const GAS f32x4*)(W + (size_t)(k0 + kk) * ldw + src_col0 + n0 + 4 * (lane & 7)); rs[i] = rscale ? rscale[k0 + kk] : 1.0f; }
#pragma unroll
        for (int i = 0; i < 8; ++i) { const int kk = 8 * i + (lane >> 3); const f32x4 t = v[i] * rs[i]; LAS float* d = scr + kk * 33 + 4 * (lane & 7); d[0] = t.x; d[1] = t.y; d[2] = t.z; d[3] = t.w; } }
    LDS_WAIT(); asm volatile("" ::: "memory");
    const int c = lane & 7;
#pragma unroll
    for (int j = 0; j < 4; ++j) { const int n = (lane >> 3) + 8 * j; const LAS float* s = scr + (8 * c) * 33 + n;
        v4u o; o.x = pk2(s[0 * 33], s[1 * 33]); o.y = pk2(s[2 * 33], s[3 * 33]); o.z = pk2(s[4 * 33], s[5 * 33]); o.w = pk2(s[6 * 33], s[7 * 33]);
        const int nn = n0 + n;
        if (MODE == 2) { const int k8 = (k0 >> 3) + c;
            *(GAS v4u*)(WT + ((size_t)(((k8 >> 2) * (dst_row0 >> 4) + (nn >> 4)) * 64 + (k8 & 3) * 16 + (nn & 15))) * 8) = o; }
        else { const int drow = (MODE == 0) ? (dst_row0 + nn) : (dst_row0 + ((nn >> 7) << 8) + (nn & 127));
            *(GAS v4u*)(WT + (size_t)drow * K + k0 + 8 * c) = o; } }
    LDS_WAIT(); asm volatile("" ::: "memory");
}
__device__ __forceinline__ int misc_src_col(int r) { return r < 4 ? 3072 + r : (r < 8 ? 3076 + (r - 4) : 4360 + (r - 8)); }
__device__ __forceinline__ int inproj_src_col(int n) {
    if (n < 3072) return n; if (n < 3584) return 3080 + (n - 3072); if (n < 4352) return 3592 + (n - 3584); if (n < 6400) return 4384 + (n - 4352); return misc_src_col(n - 6400);
}

struct Args { const float* in[22]; float* out; unsigned char* ws; int ph_lo, ph_hi; };


__device__ __forceinline__ float block_sum256(float v, LAS float* red, int stid) {
    v = wave_sum(v);
    if ((stid & 63) == 0) red[stid >> 6] = v;
    __syncthreads();
    const float r = (red[0] + red[1]) + (red[2] + red[3]);
    __syncthreads();
    return r;
}
__device__ __forceinline__ void cmp_item(const Args& args, LAS unsigned char* Ls, int id, int stid, size_t koff, size_t voff) {
    LAS float* tok = (LAS float*)Ls; LAS float* hid = tok + 2048;
    const int c = id % 511; id /= 511; const int bg = id % 8, kind = id / 8;
    const bf16* src = (const bf16*)(args.ws + WS_NKV) + (size_t)kind * pg8::NKV_KIND_ELEMS + ((size_t)bg * 8192 + 16 * c) * 64;
    const float* pos = args.in[kind ? 11 : 8]; const float* w1 = args.in[kind ? 12 : 9]; const float* w2 = args.in[kind ? 13 : 10];
    for (int i = stid; i < 2048; i += 256) tok[i] = bf2f(src[i]) + pos[i];
    __syncthreads();
    float a = 0.f;
    for (int i = 0; i < 2048; ++i) a += tok[i] * w1[(size_t)i * 256 + stid];
    hid[stid] = a * sigm(a);
    __syncthreads();
    if (stid < 64) { float o = 0.f; for (int j = 0; j < 256; ++j) o += hid[j] * w2[j * 64 + stid];
        bf16* dst = (bf16*)(args.ws + (kind ? voff : koff)) + ((size_t)bg * 512 + c) * 64 + stid; *dst = (bf16)f2bf(o); }
    __syncthreads();
}
__device__ __forceinline__ float block_sum512(float v, LAS float* red, int tid) {
    v = wave_sum(v);
    if ((tid & 63) == 0) red[tid >> 6] = v;
    __syncthreads();
    const float r = ((red[0] + red[1]) + (red[2] + red[3])) + ((red[4] + red[5]) + (red[6] + red[7]));
    __syncthreads();
    return r;
}
__device__ __forceinline__ void mlstm_scalar_bh(const Args& args, LAS unsigned char* Ls, int bh, int tid) {
    LAS bf16* qs = (LAS bf16*)Ls; LAS bf16* ks = qs + 64 * 128; LAS float* gi = (LAS float*)(ks + 64 * 128); LAS float* gf = gi + 64; LAS float* red = gf + 64;
    const int b = bh >> 2, h = bh & 3, dv = tid >> 1, hf = tid & 1;
    const bf16* QMp = (const bf16*)(args.ws + WS_QM) + (size_t)bh * 8192 * 128; const bf16* KMp = (const bf16*)(args.ws + WS_KM) + (size_t)bh * 8192 * 128;
    const bf16* VMp = (const bf16*)(args.ws + WS_VM); const bf16* OGp = (const bf16*)(args.ws + WS_OG); const float* MISCB = (const float*)(args.ws + WS_MISC);
    bf16* YAp = (bf16*)(args.ws + WS_YA);
    const float fb = args.in[4][h]; const float ng = args.in[7][h * 256 + dv];
    float C[64];
#pragma unroll
    for (int d = 0; d < 64; ++d) C[d] = 0.f;
    float nreg = 0.f, m = 0.f;
    for (int ch = 0; ch < 128; ++ch) {
        __syncthreads();
        for (int i = tid; i < 1024; i += 512) { ((LAS v4u*)qs)[i] = ((const v4u*)(QMp + (size_t)ch * 64 * 128))[i]; ((LAS v4u*)ks)[i] = ((const v4u*)(KMp + (size_t)ch * 64 * 128))[i]; }
        if (tid < 64) { const size_t row = (size_t)b * 8192 + ch * 64 + tid; gi[tid] = MISCB[row * 32 + h]; const float fp = MISCB[row * 32 + 4 + h] + fb;
            gf[tid] = fminf(fp, 0.f) - log1pf(__expf(-fabsf(fp))); }
        __syncthreads();
        for (int s = 0; s < 64; ++s) {
            const size_t row = (size_t)b * 8192 + ch * 64 + s;
            const float lf = gf[s], li = gi[s];
            const float mn = fmaxf(lf + m, li), fd = __expf(lf + m - mn), iw = __expf(li - mn);
            const float v = bf2f(VMp[row * 1024 + h * 256 + dv]); const float vi = iw * v;
            float num = 0.f, part = 0.f;
#pragma unroll
            for (int d8 = 0; d8 < 8; ++d8) {
                const v4u kw = ((const LAS v4u*)(ks + s * 128 + hf * 64))[d8], qw = ((const LAS v4u*)(qs + s * 128 + hf * 64))[d8];
                const float kk[8] = {bfl(kw.x), bfh(kw.x), bfl(kw.y), bfh(kw.y), bfl(kw.z), bfh(kw.z), bfl(kw.w), bfh(kw.w)};
                const float qq[8] = {bfl(qw.x), bfh(qw.x), bfl(qw.y), bfh(qw.y), bfl(qw.z), bfh(qw.z), bfl(qw.w), bfh(qw.w)};
#pragma unroll
                for (int i = 0; i < 8; ++i) { C[d8 * 8 + i] = fd * C[d8 * 8 + i] + vi * kk[i]; num += C[d8 * 8 + i] * qq[i]; }
            }
            num += __shfl_xor(num, 1);
            if (tid < 128) { nreg = fd * nreg + iw * bf2f(ks[s * 128 + tid]); part = nreg * bf2f(qs[s * 128 + tid]); }
            const float nq = block_sum512(part, red, tid);
            const float hv = num / fmaxf(fabsf(nq), __expf(-mn));
            const float ss = block_sum512(hf == 0 ? hv * hv : 0.f, red + 8, tid);
            const float y = hv * (1.0f / sqrtf(ss * (1.f / 256.f) + RMS_EPS)) * ng * bf2f(OGp[row * 1024 + h * 256 + dv]);
            if (hf == 0) YAp[row * 1024 + h * 256 + dv] = (bf16)f2bf(y);
            m = mn;
        }
    }
    __syncthreads();
}
__device__ __forceinline__ float dot64(const LAS float* q, const bf16* kr) {
    float s = 0.f;
#pragma unroll
    for (int d8 = 0; d8 < 8; ++d8) { const v4u w = ((const v4u*)kr)[d8]; const LAS float* qq = q + 8 * d8;
        s += qq[0] * bfl(w.x) + qq[1] * bfh(w.x) + qq[2] * bfl(w.y) + qq[3] * bfh(w.y) + qq[4] * bfl(w.z) + qq[5] * bfh(w.z) + qq[6] * bfl(w.w) + qq[7] * bfh(w.w); }
    return s;
}
__device__ __forceinline__ void nsa_scalar_item(const Args& args, LAS unsigned char* Ls, int bgt, int stid, bool valid, bf16* outp) {
    LAS float* sc = (LAS float*)Ls;
    LAS float* qsh = sc + 4096;
    LAS float* imp = qsh + 256;
    LAS float* sscore = imp + 512;
    LAS int* sel = (LAS int*)(sscore + 128);
    const int h = stid >> 6, lane = stid & 63;
    const int t = bgt & 8191, bg = bgt >> 13, b = bg >> 1, g = bg & 1;
    const size_t row = (size_t)b * 8192 + t;
    bf16* NQp = (bf16*)(args.ws + WS_NQ);
    const bf16* KCC = (const bf16*)(args.ws + WS_KCC) + (size_t)bg * 512 * 64; const bf16* VCC = (const bf16*)(args.ws + WS_VCC) + (size_t)bg * 512 * 64;
    const bf16* NKVp = (const bf16*)(args.ws + WS_NKV);
    const bf16* KS = NKVp + (size_t)2 * pg8::NKV_KIND_ELEMS + (size_t)bg * 8192 * 64; const bf16* VS = NKVp + (size_t)3 * pg8::NKV_KIND_ELEMS + (size_t)bg * 8192 * 64;
    const bf16* KW = NKVp + (size_t)4 * pg8::NKV_KIND_ELEMS + (size_t)bg * 8192 * 64; const bf16* VW = NKVp + (size_t)5 * pg8::NKV_KIND_ELEMS + (size_t)bg * 8192 * 64;
    const float* MISCB = (const float*)(args.ws + WS_MISC);
    LAS float* sch = sc + h * 1024; LAS float* qh = qsh + h * 64;
    qh[lane] = bf2f(NQp[row * 512 + (g * 4 + h) * 64 + lane]);
    for (int i = stid; i < 512; i += 256) imp[i] = 0.f;
    __syncthreads();
    const int nc = (t >= 31) ? ((t - 31) >> 4) + 1 : 0;
    float mx = -INFINITY;
    for (int c = lane; c < nc; c += 64) { const float s = dot64(qh, KCC + (size_t)c * 64); sch[c] = s; mx = fmaxf(mx, s); }
    mx = wave_max(mx);
    float sm = 0.f;
    for (int c = lane; c < nc; c += 64) { const float e = exp2f(sch[c] - mx); sch[c] = e; sm += e; }
    sm = wave_sum(sm);
    const float inv = nc > 0 ? 1.0f / sm : 0.f;
    for (int c = lane; c < nc; c += 64) sch[c] *= inv;
    __syncthreads();
    float o_cmp = 0.f;
    for (int c = 0; c < nc; ++c) o_cmp += sch[c] * bf2f(VCC[(size_t)c * 64 + lane]);
    for (int c = stid; c < nc; c += 256) imp[c] = (sc[c] + sc[1024 + c]) + (sc[2048 + c] + sc[3072 + c]);
    __syncthreads();
    const int cur = t >> 6;
    if (stid < 128) { const int j = stid; float v = 0.f;
        { const int k0 = 4 * j - 1; if (k0 >= 0 && k0 < 511) v += imp[k0]; }
#pragma unroll
        for (int q = 0; q < 3; ++q) { const int k = 4 * j + q; if (k < 511) v += 2.f * imp[k]; }
        { const int k4 = 4 * j + 3; if (k4 < 511) v += imp[k4]; }
        const bool elig = j <= cur, forced = (j == 0) || (j == cur) || (j == cur - 1);
        sscore[j] = forced ? 1e9f : (elig ? v : -1e9f); }
    __syncthreads();
    if (stid < 128) { const float s = sscore[stid]; int rank = 0;
        for (int j = 0; j < 128; ++j) { const float o = sscore[j]; rank += (o > s || (o == s && j < stid)) ? 1 : 0; }
        if (rank < 16) sel[rank] = stid; }
    __syncthreads();
    mx = -INFINITY;
    for (int i = 0; i < 16; ++i) { const int pos = sel[i] * 64 + lane; float s = -INFINITY;
        if (pos <= t) s = dot64(qh, KS + (size_t)pos * 64);
        sch[i * 64 + lane] = s; mx = fmaxf(mx, s); }
    mx = wave_max(mx); sm = 0.f;
    for (int i = 0; i < 16; ++i) { const float s = sch[i * 64 + lane]; const float e = (s == -INFINITY) ? 0.f : exp2f(s - mx); sch[i * 64 + lane] = e; sm += e; }
    sm = wave_sum(sm);
    __syncthreads();
    float o_slc = 0.f;
    for (int i = 0; i < 16; ++i) { const int p0 = sel[i] * 64; if (p0 > t) continue;
        for (int k = 0; k < 64; ++k) o_slc += sch[i * 64 + k] * bf2f(VS[(size_t)(p0 + k) * 64 + lane]); }
    o_slc /= sm;
    __syncthreads();
    mx = -INFINITY;
    for (int i = 0; i < 8; ++i) { const int pos = t - 511 + i * 64 + lane; float s = -INFINITY;
        if (pos >= 0) s = dot64(qh, KW + (size_t)pos * 64);
        sch[i * 64 + lane] = s; mx = fmaxf(mx, s); }
    mx = wave_max(mx); sm = 0.f;
    for (int i = 0; i < 8; ++i) { const float s = sch[i * 64 + lane]; const float e = (s == -INFINITY) ? 0.f : exp2f(s - mx); sch[i * 64 + lane] = e; sm += e; }
    sm = wave_sum(sm);
    __syncthreads();
    float o_win = 0.f;
    for (int k = 0; k < 512; ++k) { const int pos = t - 511 + k; if (pos < 0) continue; o_win += sch[k] * bf2f(VW[(size_t)pos * 64 + lane]); }
    o_win /= sm;
    const float* gp = MISCB + row * 32 + 8 + (g * 4 + h) * 3;
    const float o = sigm(gp[0]) * o_cmp + sigm(gp[1]) * o_slc + sigm(gp[2]) * o_win;
    if (valid) outp[row * 512 + (g * 4 + h) * 64 + lane] = (bf16)f2bf(o);
    __syncthreads();
}

namespace nsa {
typedef float f32x4 __attribute__((ext_vector_type(4)));
typedef short bf16x8 __attribute__((ext_vector_type(8)));
typedef short s16x4 __attribute__((ext_vector_type(4)));
typedef float f32x2_t __attribute__((ext_vector_type(2)));
typedef __bf16 bf16x2_t __attribute__((ext_vector_type(2)));
typedef unsigned u32x4_t __attribute__((ext_vector_type(4)));
typedef unsigned u32x2_t __attribute__((ext_vector_type(2)));
constexpr int TB = 8192, TILE2 = 2 * TB;
constexpr int OFF_SCB = 65536;
constexpr int OFF_SELM = 132096;
constexpr int OFF_UNI = OFF_SELM + 1024;
constexpr float NEGBIG = -1e30f;
__device__ __forceinline__ unsigned cvtpk(float lo, float hi) { f32x2_t v = {lo, hi}; bf16x2_t b = __builtin_convertvector(v, bf16x2_t); return __builtin_bit_cast(unsigned, b); }
__device__ __forceinline__ s16x4 tr4(const LAS unsigned char* p) { return __builtin_bit_cast(s16x4, __builtin_amdgcn_ds_read_tr16_b64_v4i16((LAS s16x4*)p)); }
__device__ __forceinline__ float dpp_xor1(float x) { return __builtin_bit_cast(float, __builtin_amdgcn_update_dpp(0, __builtin_bit_cast(int, x), 0xB1, 0xF, 0xF, true)); }
__device__ __forceinline__ float dpp_xor2(float x) { return __builtin_bit_cast(float, __builtin_amdgcn_update_dpp(0, __builtin_bit_cast(int, x), 0x4E, 0xF, 0xF, true)); }
__device__ __forceinline__ float fq_max(float x) {
    const auto a = __builtin_amdgcn_permlane16_swap(__float_as_uint(x), __float_as_uint(x), false, false); x = fmaxf(__uint_as_float(a[0]), __uint_as_float(a[1]));
    const auto b = __builtin_amdgcn_permlane32_swap(__float_as_uint(x), __float_as_uint(x), false, false); return fmaxf(__uint_as_float(b[0]), __uint_as_float(b[1]));
}
__device__ __forceinline__ float fq_sum(float x) {
    const auto a = __builtin_amdgcn_permlane16_swap(__float_as_uint(x), __float_as_uint(x), false, false); x = __uint_as_float(a[0]) + __uint_as_float(a[1]);
    const auto b = __builtin_amdgcn_permlane32_swap(__float_as_uint(x), __float_as_uint(x), false, false); return __uint_as_float(b[0]) + __uint_as_float(b[1]);
}
__device__ __forceinline__ void glds16(const void* gsrc, unsigned lds_dst) { unsigned keep;
    asm volatile("s_mov_b32 %0, m0\n\ts_mov_b32 m0, %2\n\ts_nop 0\n\tglobal_load_lds_dwordx4 %1, off\n\ts_mov_b32 m0, %0" : "=&s"(keep) : "v"(gsrc), "s"(lds_dst) : "memory"); }
#define NSA_MFMA(a, b, c) __builtin_amdgcn_mfma_f32_16x16x32_bf16(a, b, c, 0, 0, 0)
#define EX2(x) __builtin_amdgcn_exp2f(x)
__device__ __forceinline__ int cvt_rpi(float x) { int r; asm("v_cvt_rpi_i32_f32 %0, %1" : "=v"(r) : "v"(x)); return r; }
__device__ __forceinline__ float max3f(float a, float b, float c) { float r; asm("v_max3_f32 %0, %1, %2, %3" : "=v"(r) : "v"(a), "v"(b), "v"(c)); return r; }
__device__ __forceinline__ float max16(const f32x4 (&sv)[4]) {
    float a = max3f(sv[0][0], sv[0][1], sv[0][2]), b = max3f(sv[0][3], sv[1][0], sv[1][1]), c = max3f(sv[1][2], sv[1][3], sv[2][0]), d = max3f(sv[2][1], sv[2][2], sv[2][3]);
    a = max3f(a, sv[3][0], sv[3][1]); b = max3f(b, sv[3][2], sv[3][3]); a = max3f(a, b, c); return fmaxf(a, d);
}
__device__ __forceinline__ void qk_tile_c(f32x4 (&sv)[4], const LAS unsigned char* Kt, const bf16x8 (&q)[2], int ro0, int ro1, const f32x4 cinit) {
    bf16x8 kf[8];
#pragma unroll
    for (int mt = 0; mt < 4; ++mt) { kf[2 * mt] = *(const LAS bf16x8*)(Kt + mt * 2048 + ro0); kf[2 * mt + 1] = *(const LAS bf16x8*)(Kt + mt * 2048 + ro1); }
    __builtin_amdgcn_sched_barrier(0);
#pragma unroll
    for (int mt = 0; mt < 4; ++mt) sv[mt] = NSA_MFMA(kf[2 * mt], q[0], cinit);
#pragma unroll
    for (int mt = 0; mt < 4; ++mt) sv[mt] = NSA_MFMA(kf[2 * mt + 1], q[1], sv[mt]);
}
__device__ __forceinline__ void qk_tile(f32x4 (&sv)[4], const LAS unsigned char* Kt, const bf16x8 (&q)[2], int ro0, int ro1) {
    const f32x4 Z4 = {0.f, 0.f, 0.f, 0.f};
    bf16x8 kf[8];
#pragma unroll
    for (int mt = 0; mt < 4; ++mt) { kf[2 * mt] = *(const LAS bf16x8*)(Kt + mt * 2048 + ro0); kf[2 * mt + 1] = *(const LAS bf16x8*)(Kt + mt * 2048 + ro1); }
    __builtin_amdgcn_sched_barrier(0);
#pragma unroll
    for (int mt = 0; mt < 4; ++mt) sv[mt] = NSA_MFMA(kf[2 * mt], q[0], Z4);
#pragma unroll
    for (int mt = 0; mt < 4; ++mt) sv[mt] = NSA_MFMA(kf[2 * mt + 1], q[1], sv[mt]);
}
__device__ __forceinline__ void qk_tile2(f32x4 (&sa)[4], f32x4 (&sb)[4], const LAS unsigned char* Kt, const bf16x8 (&qa)[2], const bf16x8 (&qb)[2], int ro0, int ro1, const f32x4 ca, const f32x4 cb) {
    bf16x8 kf[8];
#pragma unroll
    for (int mt = 0; mt < 4; ++mt) { kf[2 * mt] = *(const LAS bf16x8*)(Kt + mt * 2048 + ro0); kf[2 * mt + 1] = *(const LAS bf16x8*)(Kt + mt * 2048 + ro1); }
    __builtin_amdgcn_sched_barrier(0);
#pragma unroll
    for (int mt = 0; mt < 4; ++mt) { sa[mt] = NSA_MFMA(kf[2 * mt], qa[0], ca); sb[mt] = NSA_MFMA(kf[2 * mt], qb[0], cb); }
#pragma unroll
    for (int mt = 0; mt < 4; ++mt) { sa[mt] = NSA_MFMA(kf[2 * mt + 1], qa[1], sa[mt]); sb[mt] = NSA_MFMA(kf[2 * mt + 1], qb[1], sb[mt]); }
}
__device__ __forceinline__ void pack_p(bf16x8 (&pk)[2], const f32x4 (&sv)[4]) {
#pragma unroll
    for (int j = 0; j < 2; ++j) { u32x4_t pw; pw.x = cvtpk(sv[2 * j][0], sv[2 * j][1]); pw.y = cvtpk(sv[2 * j][2], sv[2 * j][3]);
        pw.z = cvtpk(sv[2 * j + 1][0], sv[2 * j + 1][1]); pw.w = cvtpk(sv[2 * j + 1][2], sv[2 * j + 1][3]); pk[j] = __builtin_bit_cast(bf16x8, pw); }
}
__device__ __forceinline__ void pv_tile(f32x4 (&o)[4], const LAS unsigned char* Vt, const int (&tro)[4], const bf16x8 (&pk)[2]) {
    s16x4 lo[8], hi[8];
#pragma unroll
    for (int dt = 0; dt < 4; ++dt)
#pragma unroll
        for (int j = 0; j < 2; ++j) { lo[dt * 2 + j] = tr4(Vt + tro[dt] + j * 4096); hi[dt * 2 + j] = tr4(Vt + tro[dt] + j * 4096 + 2048); }
    __builtin_amdgcn_sched_barrier(0);
#pragma unroll
    for (int j = 0; j < 2; ++j)
#pragma unroll
        for (int dt = 0; dt < 4; ++dt) { const s16x4 a = lo[dt * 2 + j], c = hi[dt * 2 + j];
            o[dt] = NSA_MFMA(((bf16x8){a[0], a[1], a[2], a[3], c[0], c[1], c[2], c[3]}), pk[j], o[dt]); }
}
__device__ __forceinline__ void pv_tile2(f32x4 (&o0)[4], f32x4 (&o1)[4], const LAS unsigned char* Vt, const int (&tro)[4], const bf16x8 (&pk0)[2], const bf16x8 (&pk1)[2]) {
    s16x4 lo[8], hi[8];
#pragma unroll
    for (int dt = 0; dt < 4; ++dt)
#pragma unroll
        for (int j = 0; j < 2; ++j) { lo[dt * 2 + j] = tr4(Vt + tro[dt] + j * 4096); hi[dt * 2 + j] = tr4(Vt + tro[dt] + j * 4096 + 2048); }
    __builtin_amdgcn_sched_barrier(0);
#pragma unroll
    for (int j = 0; j < 2; ++j)
#pragma unroll
        for (int dt = 0; dt < 4; ++dt) { const s16x4 a = lo[dt * 2 + j], c = hi[dt * 2 + j]; const bf16x8 vf = {a[0], a[1], a[2], a[3], c[0], c[1], c[2], c[3]};
            o0[dt] = NSA_MFMA(vf, pk0[j], o0[dt]); o1[dt] = NSA_MFMA(vf, pk1[j], o1[dt]); }
}

template <int NT>
__device__ __forceinline__ void kv_tiles(const LAS unsigned char* slot, const int (&tls)[NT], const int ib, const unsigned mbits, const int br, const int qt, const int tl_tok, const int fq,
                                         const bf16x8 (&q)[2], const int ro0, const int ro1, const int (&tro)[4], f32x4& negv, float& lB, bool& first, f32x4 (&ob)[4]) {
    f32x4 sv[NT][4];
    {   bf16x8 kf[NT][8]; f32x4 cin[NT];
#pragma unroll
        for (int t = 0; t < NT; ++t) { const LAS unsigned char* Kt = slot + tls[t] * TILE2;
#pragma unroll
            for (int mt = 0; mt < 4; ++mt) { kf[t][2 * mt] = *(const LAS bf16x8*)(Kt + mt * 2048 + ro0); kf[t][2 * mt + 1] = *(const LAS bf16x8*)(Kt + mt * 2048 + ro1); } }
#pragma unroll
        for (int t = 0; t < NT; ++t) { const bool mine = (mbits >> tls[t]) & 1u;
            cin[t][0] = mine ? negv[0] : NEGBIG; cin[t][1] = mine ? negv[1] : NEGBIG; cin[t][2] = mine ? negv[2] : NEGBIG; cin[t][3] = mine ? negv[3] : NEGBIG; }
        __builtin_amdgcn_sched_barrier(0);
#pragma unroll
        for (int t = 0; t < NT; ++t)
#pragma unroll
            for (int mt = 0; mt < 4; ++mt) sv[t][mt] = NSA_MFMA(kf[t][2 * mt], q[0], cin[t]);
#pragma unroll
        for (int t = 0; t < NT; ++t)
#pragma unroll
            for (int mt = 0; mt < 4; ++mt) sv[t][mt] = NSA_MFMA(kf[t][2 * mt + 1], q[1], sv[t][mt]);
    }
#pragma unroll
    for (int t = 0; t < NT; ++t) { const int i = ib + tls[t];
        if (br == 0 ? (i == qt) : (i == 8)) {
#pragma unroll
            for (int mt = 0; mt < 4; ++mt)
#pragma unroll
                for (int r = 0; r < 4; ++r) if (16 * mt + 4 * fq + r > tl_tok) sv[t][mt][r] = NEGBIG;
        } else if (br == 1 && i == 0) {
#pragma unroll
            for (int mt = 0; mt < 4; ++mt)
#pragma unroll
                for (int r = 0; r < 4; ++r) if (16 * mt + 4 * fq + r <= tl_tok) sv[t][mt][r] = NEGBIG;
        } }
    if (first) {
        const float trow = fq_max(max16(sv[0])); const float d = fmaxf(trow, -64.0f);
        first = false; negv = negv - d;
#pragma unroll
        for (int mt = 0; mt < 4; ++mt) sv[0][mt] = sv[0][mt] - d;
    }
    f32x4 pe[NT][4]; f32x2_t ls2 = {0.f, 0.f};
#pragma unroll
    for (int t = 0; t < NT; ++t)
#pragma unroll
        for (int mt = 0; mt < 4; ++mt) {
#pragma unroll
            for (int r = 0; r < 4; ++r) pe[t][mt][r] = EX2(sv[t][mt][r]);
            ls2 += (f32x2_t){pe[t][mt][0], pe[t][mt][1]}; ls2 += (f32x2_t){pe[t][mt][2], pe[t][mt][3]}; }
    float lsum = ls2[0] + ls2[1];
    if (__any(!(lsum < 1e30f))) {
        float tm = max16(sv[0]); if (NT == 2) tm = fmaxf(tm, max16(sv[NT - 1]));
        const float trow = fq_max(tm); const float d = fmaxf(trow, 0.f); const float alpha = EX2(-d);
        negv = negv - d; lB *= alpha;
#pragma unroll
        for (int dt = 0; dt < 4; ++dt) ob[dt] = ob[dt] * alpha;
        ls2 = (f32x2_t){0.f, 0.f};
#pragma unroll
        for (int t = 0; t < NT; ++t)
#pragma unroll
            for (int mt = 0; mt < 4; ++mt) {
#pragma unroll
                for (int r = 0; r < 4; ++r) pe[t][mt][r] = EX2(sv[t][mt][r] - d);
                ls2 += (f32x2_t){pe[t][mt][0], pe[t][mt][1]}; ls2 += (f32x2_t){pe[t][mt][2], pe[t][mt][3]}; }
        lsum = ls2[0] + ls2[1];
    }
    lB += lsum;
    bf16x8 pk[NT][2];
#pragma unroll
    for (int t = 0; t < NT; ++t) pack_p(pk[t], pe[t]);
    {   s16x4 lo[NT][8], hi[NT][8];
#pragma unroll
        for (int t = 0; t < NT; ++t) { const LAS unsigned char* Vt = slot + tls[t] * TILE2 + TB;
#pragma unroll
            for (int dt = 0; dt < 4; ++dt)
#pragma unroll
                for (int j = 0; j < 2; ++j) { lo[t][dt * 2 + j] = tr4(Vt + tro[dt] + j * 4096); hi[t][dt * 2 + j] = tr4(Vt + tro[dt] + j * 4096 + 2048); } }
        __builtin_amdgcn_sched_barrier(0);
#pragma unroll
        for (int j = 0; j < 2; ++j)
#pragma unroll
            for (int t = 0; t < NT; ++t)
#pragma unroll
                for (int dt = 0; dt < 4; ++dt) { const s16x4 a = lo[t][dt * 2 + j], c = hi[t][dt * 2 + j];
                    ob[dt] = NSA_MFMA(((bf16x8){a[0], a[1], a[2], a[3], c[0], c[1], c[2], c[3]}), pk[t][j], ob[dt]); }
    }
}

__device__ __forceinline__ void nsa_unit(const Args& args, LAS unsigned char* L, int bg, int qt, int tid, const int flags = 15, const size_t yoff = WS_YB) {
#ifdef DIAG_SEL
    unsigned dq = 0u, dsx = 0u, dp = 0u, dn = 0u;
#endif
    const unsigned ldsb = (unsigned)(uintptr_t)(unsigned char*)L;
    const int lane = tid & 63, w = __builtin_amdgcn_readfirstlane(tid >> 6), n = lane & 15, fq = lane >> 4;
    const int b = bg >> 1, g = bg & 1, t0 = qt * 64;
    const bf16* KCC = (const bf16*)(args.ws + WS_KCC) + (size_t)bg * 512 * 64; const bf16* VCC = (const bf16*)(args.ws + WS_VCC) + (size_t)bg * 512 * 64;
    const bf16* NKVp = (const bf16*)(args.ws + WS_NKV);
    const bf16* KS = NKVp + (size_t)2 * pg8::NKV_KIND_ELEMS + (size_t)bg * 8192 * 64; const bf16* VS = NKVp + (size_t)3 * pg8::NKV_KIND_ELEMS + (size_t)bg * 8192 * 64;
    const bf16* KW = NKVp + (size_t)4 * pg8::NKV_KIND_ELEMS + (size_t)bg * 8192 * 64; const bf16* VW = NKVp + (size_t)5 * pg8::NKV_KIND_ELEMS + (size_t)bg * 8192 * 64;
    const float* MISCB = (const float*)(args.ws + WS_MISC);
    const bf16* NQp = (const bf16*)(args.ws + WS_NQ);
    LAS float* scb = (LAS float*)(L + OFF_SCB); LAS unsigned* selm = (LAS unsigned*)(L + OFF_SELM); LAS unsigned* uni = (LAS unsigned*)(L + OFF_UNI);
    const f32x4 Z4 = {0.f, 0.f, 0.f, 0.f};
    int ro0 = n * 128 + ((fq ^ (n & 7)) << 4), ro1 = n * 128 + (((4 + fq) ^ (n & 7)) << 4);
    if (flags & 64) { ro0 = 0; ro1 = 16; }
    int tro[4];
    { const int q = n >> 2, p = n & 3, xr = 4 * (fq & 1) + q;
#pragma unroll
      for (int dt = 0; dt < 4; ++dt) { tro[dt] = (4 * fq + q) * 128 + ((((2 * dt) ^ (xr & 6)) | ((p >> 1) ^ (xr & 1))) << 4) + (p & 1) * 8; if (flags & 128) tro[dt] = 32 * dt; } }

    bf16x8 qf[2][2]; int tlx[2]; size_t grow[2];
#pragma unroll
    for (int s = 0; s < 2; ++s) { tlx[s] = 8 * w + 4 * s + (n >> 2); grow[s] = (size_t)b * 8192 + t0 + tlx[s];
        const bf16* qp = NQp + grow[s] * 512 + (g * 4 + (n & 3)) * 64 + 8 * fq;
        qf[s][0] = *(const GAS bf16x8*)qp; qf[s][1] = *(const GAS bf16x8*)(qp + 32); }
    float gate[2][3];
#pragma unroll
    for (int s = 0; s < 2; ++s) { const float* gp = MISCB + grow[s] * 32 + 8 + (g * 4 + (n & 3)) * 3;
#pragma unroll
        for (int k = 0; k < 3; ++k) gate[s][k] = gp[k]; }
    f32x4 ot[2][4];
#pragma unroll
    for (int s = 0; s < 2; ++s)
#pragma unroll
        for (int dt = 0; dt < 4; ++dt) ot[s][dt] = Z4;

    const int nct = (4 * qt + 3 + 63) >> 6, nstA = (nct + 1) >> 1;
    const int cmin = 4 * qt - 2;
    int cl[2];
#pragma unroll
    for (int s = 0; s < 2; ++s) { const int tt = t0 + tlx[s]; cl[s] = tt >= 31 ? ((tt - 31) >> 4) : -1; }
    float mA[2] = {NEGBIG, NEGBIG}, lA[2] = {0.f, 0.f};
    __syncthreads();
    const int dsrc = (8 * w + (lane >> 3)) * 64 + (((lane & 7) ^ ((lane >> 3) & 7)) << 3);
#define NSA_DMA(NT, slot, Kg, Vg, i0, iend, withv) do { if (flags & 256) break; _Pragma("unroll") for (int tl_ = 0; tl_ < NT; ++tl_) { const int ix_ = ((i0) + tl_ < (iend)) ? (i0) + tl_ : (iend) - 1; \
        glds16((Kg) + (ptrdiff_t)ix_ * 4096 + dsrc, (unsigned)__builtin_amdgcn_readfirstlane(ldsb + (unsigned)((slot) - L) + tl_ * TILE2 + w * 1024)); \
        if (withv) glds16((Vg) + (ptrdiff_t)ix_ * 4096 + dsrc, (unsigned)__builtin_amdgcn_readfirstlane(ldsb + (unsigned)((slot) - L) + tl_ * TILE2 + TB + w * 1024)); } } while (0)
#define NSA_SYNC() do { asm volatile("s_waitcnt vmcnt(0)" ::: "memory"); __syncthreads(); } while (0)
#ifndef NSA_AREP
#define NSA_AREP 1
#endif
#pragma unroll 1
    for (int arep = 0; arep < NSA_AREP; ++arep) {
    mA[0] = NEGBIG; mA[1] = NEGBIG; lA[0] = 0.f; lA[1] = 0.f;
#define A_SLOT(i) ((i) < 4 ? (unsigned)(i) * TILE2 : 98304u + (unsigned)((i) - 4) * TILE2)
    if (!(flags & 256)) {
#pragma unroll
        for (int i = 0; i < 8; ++i) if (i < nct) {
            glds16(KCC + (ptrdiff_t)i * 4096 + dsrc, (unsigned)__builtin_amdgcn_readfirstlane(ldsb + (i < 6 ? A_SLOT(i) : 65536u + (unsigned)(i - 6) * TB) + w * 1024));
            if (i < 6) glds16(VCC + (ptrdiff_t)i * 4096 + dsrc, (unsigned)__builtin_amdgcn_readfirstlane(ldsb + A_SLOT(i) + TB + w * 1024)); } }
    NSA_SYNC();
    __builtin_amdgcn_s_waitcnt(0x0F70);
    if (arep == 0) {
#pragma unroll
        for (int s = 0; s < 2; ++s)
#pragma unroll
            for (int k = 0; k < 3; ++k) gate[s][k] = 1.0f / (1.0f + __expf(-gate[s][k])); }
#pragma unroll 1
    for (int i = 0; i < nct; ++i) { const LAS unsigned char* Kt1 = L + (i < 6 ? A_SLOT(i) : 65536u + (unsigned)(i - 6) * TB);
            const bool bnd = 64 * i + 63 > cmin;
            f32x4 sv2[2][4]; qk_tile2(sv2[0], sv2[1], Kt1, qf[0], qf[1], ro0, ro1, Z4, Z4);
#pragma unroll
            for (int s = 0; s < 2; ++s) { f32x4 (&sv)[4] = sv2[s];
                if (bnd) { asm volatile("" ::: "memory");
#pragma unroll
                    for (int mt = 0; mt < 4; ++mt)
#pragma unroll
                        for (int r = 0; r < 4; ++r) if (64 * i + 16 * mt + 4 * fq + r > cl[s]) sv[mt][r] = NEGBIG; }
                float tm = fmaxf(fmaxf(sv[0][0], sv[0][1]), fmaxf(sv[0][2], sv[0][3]));
#pragma unroll
                for (int mt = 1; mt < 4; ++mt) tm = fmaxf(tm, fmaxf(fmaxf(sv[mt][0], sv[mt][1]), fmaxf(sv[mt][2], sv[mt][3])));
                const float mn = fmaxf(mA[s], tm); const float me = mn > -1e29f ? mn : 1e30f; float ls = lA[s] * EX2(mA[s] - mn);
#pragma unroll
                for (int mt = 0; mt < 4; ++mt)
#pragma unroll
                    for (int r = 0; r < 4; ++r) ls += EX2(sv[mt][r] - me);
                mA[s] = mn; lA[s] = ls; } }
    __syncthreads();
    float invA[2], cA[2];
#pragma unroll
    for (int s = 0; s < 2; ++s) { const float M = fq_max(mA[s]); const float l = fq_sum(lA[s] * EX2(mA[s] - M));
        mA[s] = M > -1e29f ? M : 1e30f; invA[s] = l > 0.f ? 1.0f / l : 0.f;
        cA[s] = l > 0.f ? -M - __builtin_amdgcn_logf(l) : NEGBIG; }
    {
        f32x4 oc[2][4];
#pragma unroll
        for (int s = 0; s < 2; ++s)
#pragma unroll
            for (int dt = 0; dt < 4; ++dt) oc[s][dt] = Z4;
        float y3prev[2] = {0.f, 0.f};
#pragma unroll 1
        for (int i = 0; i < nct; ++i) {
            {   if (i == 6) NSA_SYNC();
                const bool bnd = 64 * i + 63 > cmin; const LAS unsigned char* Kt = L + (i < 6 ? A_SLOT(i) : (unsigned)(i - 6) * TILE2); const LAS unsigned char* Vt = Kt + TB;
                bf16x8 pk[2][2];
                f32x4 sv2[2][4]; { const f32x4 ca = {cA[0], cA[0], cA[0], cA[0]}, cb = {cA[1], cA[1], cA[1], cA[1]}; qk_tile2(sv2[0], sv2[1], Kt, qf[0], qf[1], ro0, ro1, ca, cb); }
#pragma unroll
                for (int s = 0; s < 2; ++s) { f32x4 (&sv)[4] = sv2[s];
                    if (bnd) { asm volatile("" ::: "memory");
#pragma unroll
                        for (int mt = 0; mt < 4; ++mt)
#pragma unroll
                            for (int r = 0; r < 4; ++r) if (64 * i + 16 * mt + 4 * fq + r > cl[s]) sv[mt][r] = NEGBIG; }
                    float a[4], c3[4];
#pragma unroll
                    for (int mt = 0; mt < 4; ++mt) {
#pragma unroll
                        for (int r = 0; r < 4; ++r) sv[mt][r] = EX2(sv[mt][r]);
                        float aa = 2.f * (sv[mt][0] + sv[mt][1] + sv[mt][2]) + sv[mt][3], cc = sv[mt][3];
                        aa += dpp_xor1(aa); aa += dpp_xor2(aa); cc += dpp_xor1(cc); cc += dpp_xor2(cc);
                        a[mt] = aa; c3[mt] = cc; }
                    float y[4];
#pragma unroll
                    for (int mt = 0; mt < 4; ++mt) y[mt] = __shfl(c3[mt], (lane + 48) & 63);
                    if ((n & 3) == 0) {
#pragma unroll
                        for (int mt = 0; mt < 4; ++mt) { const float prev = (fq > 0) ? y[mt] : (mt > 0 ? y[mt > 0 ? mt - 1 : 0] : y3prev[s]);
                            scb[tlx[s] * 128 + 16 * i + 4 * mt + fq] = a[mt] + prev; } }
                    y3prev[s] = y[3];
                    pack_p(pk[s], sv); }
                pv_tile2(oc[0], oc[1], Vt, tro, pk[0], pk[1]); }
            if (i == 1 && nct > 6) { __syncthreads();
                if (!(flags & 256)) for (int i2 = 6; i2 < nct; ++i2) {
                    glds16(KCC + (ptrdiff_t)i2 * 4096 + dsrc, (unsigned)__builtin_amdgcn_readfirstlane(ldsb + (unsigned)(i2 - 6) * TILE2 + w * 1024));
                    glds16(VCC + (ptrdiff_t)i2 * 4096 + dsrc, (unsigned)__builtin_amdgcn_readfirstlane(ldsb + (unsigned)(i2 - 6) * TILE2 + TB + w * 1024)); } }
        }
        __syncthreads();
#undef A_SLOT
#pragma unroll
        for (int s = 0; s < 2; ++s)
#pragma unroll
            for (int dt = 0; dt < 4; ++dt) ot[s][dt] = oc[s][dt] * gate[s][0];
    }
    }
#ifndef NSA_COMPACT
#define NSA_COMPACT 1
#endif
    const bool cpath = (flags & 4) && !(flags & 512) && (NSA_COMPACT != 0);
    if (cpath) {
        const int ntd = qt + 1 < 3 ? qt + 1 : 3; const int dl[3] = {0, qt >= 2 ? qt - 1 : 1, qt};
#pragma unroll
        for (int k = 0; k < 3; ++k) if (k < ntd) {
            glds16(KS + (ptrdiff_t)dl[k] * 4096 + dsrc, (unsigned)__builtin_amdgcn_readfirstlane(ldsb + k * TILE2 + w * 1024));
            glds16(VS + (ptrdiff_t)dl[k] * 4096 + dsrc, (unsigned)__builtin_amdgcn_readfirstlane(ldsb + k * TILE2 + TB + w * 1024)); }
    }
    if (flags & 2) {
        unsigned long long ulo[2] = {0ull, 0ull}, uhi[2] = {0ull, 0ull};
        if (qt < 16) {
            const unsigned long long m = (1ull << (qt + 1)) - 1ull;
            if (lane < 8) { selm[(8 * w + lane) * 4 + 0] = (unsigned)m; selm[(8 * w + lane) * 4 + 1] = 0u; selm[(8 * w + lane) * 4 + 2] = 0u; selm[(8 * w + lane) * 4 + 3] = 0u; }
            ulo[0] = m; ulo[1] = m;
        } else {
            unsigned k0[8], k1[8], T[8];
#pragma unroll
            for (int tk = 0; tk < 8; ++tk) { const int tl = 8 * w + tk; const float s0 = scb[tl * 128 + lane], s1 = scb[tl * 128 + 64 + lane];
                const int j0 = lane, j1 = lane + 64;
                k0[tk] = (j0 >= 1 && j0 <= qt - 2) ? __float_as_uint(s0) + 1u : 0u; k1[tk] = (j1 >= 1 && j1 <= qt - 2) ? __float_as_uint(s1) + 1u : 0u; T[tk] = 0u; }
            unsigned done = 0u;
            for (int bit = 30; bit >= 0 && done != 0xFFu; --bit) {
#pragma unroll
                for (int tk = 0; tk < 8; ++tk) { if ((done >> tk) & 1u) continue; const unsigned cand = T[tk] | (1u << bit);
                    const int cnt = __popcll(__ballot(k0[tk] >= cand)) + __popcll(__ballot(k1[tk] >= cand));
                    if (cnt >= 13) T[tk] = cand; if (cnt == 13) done |= 1u << tk; }
            }
#pragma unroll
            for (int tk = 0; tk < 8; ++tk) {
                unsigned long long lo = __ballot(k0[tk] > T[tk]), hi = __ballot(k1[tk] > T[tk]);
                unsigned long long e0 = __ballot(k0[tk] == T[tk]), e1 = __ballot(k1[tk] == T[tk]);
                int need = 13 - (__popcll(lo) + __popcll(hi));
                while (need > 0 && (e0 | e1)) { if (e0) { const unsigned long long bbit = e0 & (0ull - e0); lo |= bbit; e0 ^= bbit; } else { const unsigned long long bbit = e1 & (0ull - e1); hi |= bbit; e1 ^= bbit; } --need; }
                lo |= 1ull;
                if (qt - 1 < 64) lo |= 1ull << (qt - 1); else hi |= 1ull << (qt - 1 - 64);
                if (qt < 64) lo |= 1ull << qt; else hi |= 1ull << (qt - 64);
                if (lane == 0) { const int tl = 8 * w + tk; selm[tl * 4 + 0] = (unsigned)lo; selm[tl * 4 + 1] = (unsigned)(lo >> 32); selm[tl * 4 + 2] = (unsigned)hi; selm[tl * 4 + 3] = (unsigned)(hi >> 32); }
                ulo[tk >> 2] |= lo; uhi[tk >> 2] |= hi;
            }
        }
        if (lane == 0) {
#pragma unroll
            for (int s = 0; s < 2; ++s) { uni[(w * 2 + s) * 4 + 0] = (unsigned)ulo[s]; uni[(w * 2 + s) * 4 + 1] = (unsigned)(ulo[s] >> 32); uni[(w * 2 + s) * 4 + 2] = (unsigned)uhi[s]; uni[(w * 2 + s) * 4 + 3] = (unsigned)(uhi[s] >> 32); }
        }
    }
    NSA_SYNC();
    bool cdone = false;
    if (cpath) {
        constexpr int OFF_QTAB = 0, OFF_OACC = 49152, OTOK = 261 * 4, OHEAD = 65 * 4, OFF_LACC = OFF_OACC + 64 * OTOK, OFF_REFM = OFF_LACC + 2048, OFF_CCTL = OFF_REFM + 1024;
        LAS int* lfin = (LAS int*)(L + OFF_LACC); LAS int* lcrs = lfin + 256; LAS float* refm = (LAS float*)(L + OFF_REFM); LAS unsigned* cctl = (LAS unsigned*)(L + OFF_CCTL);
        const int ntd = qt + 1 < 3 ? qt + 1 : 3; const int dl[3] = {0, qt >= 2 ? qt - 1 : 1, qt};
        float lB[2] = {0.f, 0.f}; f32x4 negv[2] = {Z4, Z4}; bool first[2] = {true, true};
        f32x4 ob[2][4];
#pragma unroll
        for (int s = 0; s < 2; ++s)
#pragma unroll
            for (int dt = 0; dt < 4; ++dt) ob[s][dt] = Z4;
#pragma unroll 1
        for (int k = 0; k < ntd; ++k) { const int tls1[1] = {k}; const int dk = k == 0 ? 0 : (k == 1 ? dl[1] : dl[2]);
#pragma unroll
            for (int s = 0; s < 2; ++s) kv_tiles<1>(L, tls1, dk - k, ~0u, 0, qt, tlx[s], fq, qf[s], ro0, ro1, tro, negv[s], lB[s], first[s], ob[s]); }
        if (tid == 0) { cctl[0] = 1u; cctl[1] = 0u; }
#pragma unroll
        for (int s = 0; s < 2; ++s) { const int row = tlx[s] * 4 + (n & 3); const float l = fq_sum(lB[s]);
            if (fq == 0) { lfin[row] = __float2int_rn(l * 65536.0f); lcrs[row] = __float2int_rn(l * 256.0f); refm[row] = -negv[s][0]; }
            LAS int* op = (LAS int*)(L + OFF_OACC + tlx[s] * OTOK + (n & 3) * OHEAD) + 4 * fq;
#pragma unroll
            for (int dt = 0; dt < 4; ++dt)
#pragma unroll
                for (int r = 0; r < 4; ++r) op[16 * dt + r] = __float2int_rn(ob[s][dt][r] * 65536.0f); }
        __syncthreads();
#pragma unroll
        for (int s = 0; s < 2; ++s) { const int row = tlx[s] * 4 + (n & 3);
#pragma unroll
            for (int ks = 0; ks < 2; ++ks) *(LAS bf16x8*)(L + OFF_QTAB + row * 128 + (((4 * ks + fq) ^ (row & 7)) << 4)) = qf[s][ks]; }
        __syncthreads();
        f32x4* park = (f32x4*)(args.ws + WS_PARK) + (size_t)blockIdx.x * 8 * 512 + tid;
#pragma unroll
        for (int s = 0; s < 2; ++s)
#pragma unroll
            for (int dt = 0; dt < 4; ++dt) park[(s * 4 + dt) * 512] = ot[s][dt];
        {   const int jmax = qt - 2;
            const bf16* KSF = (const bf16*)(args.ws + WS_KSF) + (size_t)bg * 128 * 4096 + lane * 8; const bf16* VSF = (const bf16*)(args.ws + WS_VSF) + (size_t)bg * 128 * 4096 + lane * 8;
            int j = 0x7fffffff;
            { unsigned jj_ = 0u; if (lane == 0) jj_ = __hip_atomic_fetch_add(cctl, 1u, __ATOMIC_RELAXED, __HIP_MEMORY_SCOPE_WORKGROUP); j = (int)__builtin_amdgcn_readfirstlane(jj_); }
            bf16x8 kfr[8], kfn[8], vfr[8];
            if (j <= jmax) {
#pragma unroll
                for (int f = 0; f < 8; ++f) kfr[f] = *(const GAS bf16x8*)(KSF + (size_t)j * 4096 + f * 512); }
            while (j <= jmax) {
                int jn; { unsigned jj_ = 0u; if (lane == 0) jj_ = __hip_atomic_fetch_add(cctl, 1u, __ATOMIC_RELAXED, __HIP_MEMORY_SCOPE_WORKGROUP); jn = (int)__builtin_amdgcn_readfirstlane(jj_); }
#pragma unroll
                for (int f = 0; f < 8; ++f) vfr[f] = *(const GAS bf16x8*)(VSF + (size_t)j * 4096 + f * 512);
                if (jn <= jmax) {
#pragma unroll
                    for (int f = 0; f < 8; ++f) kfn[f] = *(const GAS bf16x8*)(KSF + (size_t)jn * 4096 + f * 512); }
                unsigned long long hm = __ballot((selm[lane * 4 + (j >> 5)] >> (j & 31)) & 1u);
                int tkc = 0, rowc = 0; bool validc = false; bf16x8 q0, q1; float cv = NEGBIG;
#define CX_PICK() do { int t0g = __builtin_ctzll(hm), t1g = -1, t2g = -1, t3g = -1; hm &= hm - 1ull; \
                    if (hm) { t1g = __builtin_ctzll(hm); hm &= hm - 1ull; } if (hm) { t2g = __builtin_ctzll(hm); hm &= hm - 1ull; } if (hm) { t3g = __builtin_ctzll(hm); hm &= hm - 1ull; } \
                    const int cs_ = n >> 2; const int myt_ = cs_ == 0 ? t0g : cs_ == 1 ? t1g : cs_ == 2 ? t2g : t3g; validc = myt_ >= 0; tkc = validc ? myt_ : t0g; rowc = tkc * 4 + (n & 3); \
                    q0 = *(const LAS bf16x8*)(L + OFF_QTAB + rowc * 128 + ((fq ^ (rowc & 7)) << 4)); q1 = *(const LAS bf16x8*)(L + OFF_QTAB + rowc * 128 + (((4 + fq) ^ (rowc & 7)) << 4)); \
                    cv = validc ? 16.0f - refm[rowc] : NEGBIG; } while (0)
                bool more = hm != 0ull;
                if (more) CX_PICK();
                while (more) {
                    const f32x4 cin = {cv, cv, cv, cv};
                    f32x4 sv[4];
#pragma unroll
                    for (int mt = 0; mt < 4; ++mt) sv[mt] = NSA_MFMA(kfr[2 * mt], q0, cin);
#pragma unroll
                    for (int mt = 0; mt < 4; ++mt) sv[mt] = NSA_MFMA(kfr[2 * mt + 1], q1, sv[mt]);
                    const int tk = tkc, row = rowc; const bool valid = validc;
                    f32x2_t ls2 = {0.f, 0.f};
#pragma unroll
                    for (int mt = 0; mt < 4; ++mt) {
#pragma unroll
                        for (int r = 0; r < 4; ++r) sv[mt][r] = EX2(sv[mt][r]);
                        ls2 += (f32x2_t){sv[mt][0], sv[mt][1]}; ls2 += (f32x2_t){sv[mt][2], sv[mt][3]}; }
                    const float lsum = ls2[0] + ls2[1];
                    if (__any(!(lsum < 2048.0f * 65536.0f))) { if (lane == 0) cctl[1] = 1u; }
                    bf16x8 pk[2]; pack_p(pk, sv);
                    more = hm != 0ull;
                    if (more) CX_PICK();
                    f32x4 o[4] = {Z4, Z4, Z4, Z4};
#pragma unroll
                    for (int jj = 0; jj < 2; ++jj)
#pragma unroll
                        for (int dt = 0; dt < 4; ++dt) o[dt] = NSA_MFMA(vfr[2 * dt + jj], pk[jj], o[dt]);
                    const float lrow = fq_sum(lsum);
#ifndef NSA_CX_NOATOM
                    if (valid) { LAS int* op = (LAS int*)(L + OFF_OACC + tk * OTOK + (n & 3) * OHEAD) + 4 * fq;
#pragma unroll
                        for (int dt = 0; dt < 4; ++dt)
#pragma unroll
                            for (int r = 0; r < 4; ++r) (void)__hip_atomic_fetch_add(op + 16 * dt + r, cvt_rpi(o[dt][r]), __ATOMIC_RELAXED, __HIP_MEMORY_SCOPE_WORKGROUP);
                        if (fq == 0) { (void)__hip_atomic_fetch_add(lfin + row, cvt_rpi(lrow), __ATOMIC_RELAXED, __HIP_MEMORY_SCOPE_WORKGROUP);
                                       (void)__hip_atomic_fetch_add(lcrs + row, cvt_rpi(lrow * (1.0f / 256.0f)), __ATOMIC_RELAXED, __HIP_MEMORY_SCOPE_WORKGROUP); } }
#else
                    asm volatile("" :: "v"(o[0]), "v"(o[1]), "v"(o[2]), "v"(o[3]), "v"(lrow));
#endif
                }
#undef CX_PICK
#pragma unroll
                for (int f = 0; f < 8; ++f) kfr[f] = kfn[f];
                j = jn;
            }
        }
        __syncthreads();
        const float vmax_g = ((const float*)(args.ws + WS_VMAX))[bg];
#pragma unroll
        for (int s = 0; s < 2; ++s) {
#pragma unroll
            for (int dt = 0; dt < 4; ++dt) ot[s][dt] = park[(s * 4 + dt) * 512];
            const bf16* qp = NQp + grow[s] * 512 + (g * 4 + (n & 3)) * 64 + 8 * fq; qf[s][0] = *(const GAS bf16x8*)qp; qf[s][1] = *(const GAS bf16x8*)(qp + 32); }
        {
            const float vmax = vmax_g; const float lim = 16000.0f / fmaxf(vmax, 1.0f);
            bool bad = false;
#pragma unroll
            for (int s = 0; s < 2; ++s) bad = bad || ((float)lcrs[tlx[s] * 4 + (n & 3)] * (1.0f / 256.0f) >= lim);
            if (__any(bad)) { if (lane == 0) cctl[1] = 1u; }
        }
        __syncthreads();
        cdone = cctl[1] == 0u && (NSA_COMPACT == 1);
        __builtin_amdgcn_s_waitcnt(0x0F70);
        if (cdone) {
#pragma unroll
            for (int s = 0; s < 2; ++s) { const int row = tlx[s] * 4 + (n & 3); const float sc = gate[s][1] / (float)lfin[row];
                const LAS int* op = (const LAS int*)(L + OFF_OACC + tlx[s] * OTOK + (n & 3) * OHEAD) + 4 * fq;
#pragma unroll
                for (int dt = 0; dt < 4; ++dt)
#pragma unroll
                    for (int r = 0; r < 4; ++r) ot[s][dt][r] += (float)op[16 * dt + r] * sc; }
        }
        __syncthreads();
    }
#ifndef NSA_DREP
#define NSA_DREP 1
#endif
#pragma unroll 1
    for (int rep = 0; rep < NSA_DREP; ++rep)
#pragma unroll 1
    for (int br = cdone ? 1 : 0; br < 2; ++br) {
        if (!((flags >> (2 + br)) & 1)) continue;
        const int i_begin = br == 0 ? 0 : (qt >= 8 ? 0 : 8 - qt), i_end = br == 0 ? qt + 1 : 9;
        const bf16* Kg = br == 0 ? KS : KW + (ptrdiff_t)(t0 - 512) * 64; const bf16* Vg = br == 0 ? VS : VW + (ptrdiff_t)(t0 - 512) * 64;
        const int nst = (i_end - i_begin + 3) >> 2;
        unsigned mym[2][4] = {{~0u, ~0u, ~0u, ~0u}, {~0u, ~0u, ~0u, ~0u}}, unm[2][4] = {{~0u, ~0u, ~0u, ~0u}, {~0u, ~0u, ~0u, ~0u}};
        if (br == 0) {
#pragma unroll
            for (int s = 0; s < 2; ++s)
#pragma unroll
                for (int k = 0; k < 4; ++k) { mym[s][k] = selm[tlx[s] * 4 + k]; unm[s][k] = __builtin_amdgcn_readfirstlane(uni[(w * 2 + s) * 4 + k]); } }
        float lB[2] = {0.f, 0.f}; f32x4 negv[2] = {Z4, Z4}; bool first[2] = {true, true};
        const f32x4 NEGV = {NEGBIG, NEGBIG, NEGBIG, NEGBIG};
        f32x4 ob[2][4];
#pragma unroll
        for (int s = 0; s < 2; ++s)
#pragma unroll
            for (int dt = 0; dt < 4; ++dt) ob[s][dt] = Z4;
        NSA_DMA(4, L, Kg, Vg, i_begin, i_end, true);
        NSA_SYNC();
        for (int st = 0; st < nst; ++st) {
            const int ib = i_begin + 4 * st;
            if (st + 1 < nst) NSA_DMA(4, L + ((st + 1) & 1) * 65536, Kg, Vg, ib + 4, i_end, true);
            const LAS unsigned char* slot = L + (st & 1) * 65536;
#pragma unroll
            for (int s = 0; s < 2; ++s) {
                const int wsel = ib >> 5, sh = ib & 31;
                const unsigned uwd = wsel == 0 ? unm[s][0] : wsel == 1 ? unm[s][1] : wsel == 2 ? unm[s][2] : unm[s][3];
                const unsigned mwd = wsel == 0 ? mym[s][0] : wsel == 1 ? mym[s][1] : wsel == 2 ? mym[s][2] : mym[s][3];
                const unsigned ubits = (uwd >> sh) & 15u, mbits = (mwd >> sh) & 15u;
                unsigned bits = ubits & ((i_end - ib >= 4) ? 15u : ((1u << (i_end - ib)) - 1u));
                if (flags & 16) bits = 0u;
                while (bits) {
                    const int ta = __builtin_ctz(bits); bits &= bits - 1u;
#ifdef NSA_DUAL
                    if (!first[s] && bits) { const int tb = __builtin_ctz(bits); bits &= bits - 1u; const int tls2[2] = {ta, tb};
                        kv_tiles<2>(slot, tls2, ib, mbits, br, qt, tlx[s], fq, qf[s], ro0, ro1, tro, negv[s], lB[s], first[s], ob[s]); }
                    else
#endif
                    { const int tls1[1] = {ta};
                        kv_tiles<1>(slot, tls1, ib, mbits, br, qt, tlx[s], fq, qf[s], ro0, ro1, tro, negv[s], lB[s], first[s], ob[s]); }
                }
            }
            NSA_SYNC();
        }
#pragma unroll
        for (int s = 0; s < 2; ++s) { const float l = fq_sum(lB[s]); const float sc = (rep > 0 ? 0.f : 1.f) * (br == 0 ? gate[s][1] : gate[s][2]) / l;
#pragma unroll
            for (int dt = 0; dt < 4; ++dt) ot[s][dt] = ot[s][dt] + ob[s][dt] * sc; }
    }
#ifdef DIAG_SEL
    if (flags == 15 && tid == 0) { unsigned* dg = (unsigned*)(args.ws + 768 * 1024);
        atomicAdd(dg + 0, dq >> 4); atomicAdd(dg + 1, dsx >> 4); atomicAdd(dg + 2, dp >> 4); atomicAdd(dg + 3, dn); }
#endif
#pragma unroll
    for (int s = 0; s < 2; ++s) { bf16* op = (bf16*)(args.ws + yoff) + grow[s] * 512 + (g * 4 + (n & 3)) * 64 + 4 * fq;
#pragma unroll
        for (int dt = 0; dt < 4; ++dt) { u32x2_t wv; wv.x = cvtpk(ot[s][dt][0], ot[s][dt][1]); wv.y = cvtpk(ot[s][dt][2], ot[s][dt][3]); *(GAS u32x2_t*)(op + 16 * dt) = wv; } }
#undef NSA_DMA
#undef NSA_SYNC
}
#undef NSA_MFMA
#undef EX2
}

constexpr size_t WS_GPB = 46 * MiB, WS_GPG = WS_GPB + 512 * 1024, WS_GPPM = WS_GPG + 512 * 1024, WS_GPW = WS_GPPM + 512 * 1024;
constexpr size_t WS_GPMC = 1 * MiB + 64 * 1024, WS_GPBL = WS_GPMC + 8192, WS_GPGM = WS_GPBL + 8192;
constexpr size_t WS_NST = 37 * MiB;
namespace mls {
using nsa::f32x4; using nsa::bf16x8; using nsa::s16x4; using nsa::u32x4_t; using nsa::u32x2_t; using nsa::cvtpk; using nsa::tr4;
#define MLS_MFMA(a, b, c) __builtin_amdgcn_mfma_f32_16x16x32_bf16(a, b, c, 0, 0, 0)
__device__ __forceinline__ bf16x8 rowfrag(const LAS unsigned char* tile, int rs, int row, int ks, int lane) { return *(const LAS bf16x8*)(tile + row * rs + ks * 64 + (lane >> 4) * 16); }
__device__ __forceinline__ bf16x8 trfrag_nat(const LAS unsigned char* tile, int rs, int col0, int ks, int lane) {
    const int i = lane & 15, fq = lane >> 4, q = i >> 2, p = i & 3;
    const LAS unsigned char* a0 = tile + (32 * ks + 8 * fq + q) * rs + (col0 + 4 * p) * 2;
    const s16x4 lo = tr4(a0), hi = tr4(a0 + 4 * rs);
    return (bf16x8){lo[0], lo[1], lo[2], lo[3], hi[0], hi[1], hi[2], hi[3]};
}
__device__ __forceinline__ float logsig(float x) { return fminf(x, 0.f) - log1pf(__expf(-fabsf(x))); }

__device__ __forceinline__ void gate_chunk(const Args& args, int bh, int c, int lane) {
    const int b = bh >> 2, h = bh & 3; const float fb = args.in[4][h];
    const float* MISCB = (const float*)(args.ws + WS_MISC);
    const int t = c * 64 + lane; const size_t row = (size_t)b * 8192 + t;
    const float li = MISCB[row * 32 + h], lf = logsig(MISCB[row * 32 + 4 + h] + fb);
    float bc = lf;
#pragma unroll
    for (int o = 1; o < 64; o <<= 1) { const float v = __shfl_up(bc, o); if (lane >= o) bc += v; }
    const float g = li - bc; float px = g;
#pragma unroll
    for (int o = 1; o < 64; o <<= 1) { const float v = __shfl_up(px, o); if (lane >= o) px = fmaxf(px, v); }
    ((float*)(args.ws + WS_GPB))[bh * 8192 + t] = bc; ((float*)(args.ws + WS_GPG))[bh * 8192 + t] = g; ((float*)(args.ws + WS_GPPM))[bh * 8192 + t] = px;
    if (lane == 63) { ((float*)(args.ws + WS_GPBL))[bh * 128 + c] = bc; ((float*)(args.ws + WS_GPGM))[bh * 128 + c] = px; }
}
__device__ __forceinline__ void gate_scan2(const Args& args, int bh, int lane, LAS float* mcs, LAS float* p63, bool store) {
    const float* GPBL = (const float*)(args.ws + WS_GPBL) + bh * 128; const float* GPGM = (const float*)(args.ws + WS_GPGM) + bh * 128;
    const float bl0 = GPBL[lane], bl1 = GPBL[64 + lane], gm0 = GPGM[lane], gm1 = GPGM[64 + lane];
    float m = 0.f, mc0 = 0.f, mc1 = 0.f, pp0 = 0.f, pp1 = 0.f;
    for (int c = 0; c < 64; ++c) { const float bl = __shfl(bl0, c), gm = __shfl(gm0, c); const float p = fmaxf(m, gm); if (lane == c) { mc0 = m; pp0 = p; } m = bl + p; }
    for (int c = 0; c < 64; ++c) { const float bl = __shfl(bl1, c), gm = __shfl(gm1, c); const float p = fmaxf(m, gm); if (lane == c) { mc1 = m; pp1 = p; } m = bl + p; }
    mcs[lane] = mc0; mcs[64 + lane] = mc1; p63[lane] = pp0; p63[64 + lane] = pp1;
    if (store) { float* GPMC = (float*)(args.ws + WS_GPMC) + bh * 128; GPMC[lane] = mc0; GPMC[64 + lane] = mc1; }
}

constexpr int SC_KRS = 272, SC_VRS = 272, SC_KT = 64 * SC_KRS, SC_VT = 64 * SC_VRS, SC_SLOT = SC_KT + SC_VT + 256, SC_NT = 8;
__device__ __forceinline__ void state_scan(const Args& args, LAS unsigned char* L, int bh, int sl, int tid) {
    const int lane = tid & 63, w = __builtin_amdgcn_readfirstlane(tid >> 6), n = lane & 15, fq = lane >> 4;
    const int b = bh >> 2, h = bh & 3;
    const bf16* KMp = (const bf16*)(args.ws + WS_KM) + (size_t)bh * 8192 * 128;
    const bf16* VMp = (const bf16*)(args.ws + WS_VM) + (size_t)b * 8192 * 1024 + h * 256 + sl * 128;
    const float* GPG = (const float*)(args.ws + WS_GPG) + bh * 8192;
    LAS float* mcs = (LAS float*)(L + 2 * SC_SLOT); LAS float* p63 = mcs + 128;
    __syncthreads();
    if (w == 0) gate_scan2(args, bh, lane, mcs, p63, sl == 0);
    __syncthreads();
    bf16* CST = (bf16*)args.out + (size_t)bh * 128 * 32768;
    float* NST = (float*)(args.ws + WS_NST) + (size_t)bh * 128 * 128;
    const f32x4 Z4 = {0.f, 0.f, 0.f, 0.f};
    f32x4 acc[SC_NT], accn = Z4;
#pragma unroll
    for (int nt = 0; nt < SC_NT; ++nt) acc[nt] = Z4;
    struct SReg { v4u k0, k1, v0, v1; float w; };
    SReg ra, rb, rc, rd;
#define SC_LOAD(R, cc) do { const bf16* kc_ = KMp + (size_t)(cc) * 64 * 128; (R).k0 = *(const GAS v4u*)(kc_ + tid * 8); (R).k1 = *(const GAS v4u*)(kc_ + (tid + 512) * 8); \
        (R).v0 = *(const GAS v4u*)(VMp + (size_t)((cc) * 64 + (tid >> 4)) * 1024 + (tid & 15) * 8); (R).v1 = *(const GAS v4u*)(VMp + (size_t)((cc) * 64 + 32 + (tid >> 4)) * 1024 + (tid & 15) * 8); (R).w = 0.f; if (tid < 64) (R).w = __expf(GPG[(cc) * 64 + tid] - p63[cc]); } while (0)
#define SC_STORE(R, slot) do { LAS unsigned char* D_ = L + (slot) * SC_SLOT; *(LAS v4u*)(D_ + (tid >> 4) * SC_KRS + (tid & 15) * 16) = (R).k0; *(LAS v4u*)(D_ + ((tid + 512) >> 4) * SC_KRS + (tid & 15) * 16) = (R).k1; \
        *(LAS v4u*)(D_ + SC_KT + (tid >> 4) * SC_VRS + (tid & 15) * 16) = (R).v0; *(LAS v4u*)(D_ + SC_KT + (32 + (tid >> 4)) * SC_VRS + (tid & 15) * 16) = (R).v1; if (tid < 64) ((LAS float*)(D_ + SC_KT + SC_VT))[tid] = (R).w; } while (0)
#define SC_STEP(c, RL, RS) do { \
        if ((c) + 4 < 128) SC_LOAD(RL, (c) + 4); \
        { bf16* cs = CST + (size_t)(c) * 32768 + (size_t)(sl * 128 + n) * 128 + 16 * w + 4 * fq; \
          _Pragma("unroll") for (int nt = 0; nt < SC_NT; ++nt) { u32x2_t wv; wv.x = cvtpk(acc[nt][0], acc[nt][1]); wv.y = cvtpk(acc[nt][2], acc[nt][3]); *(GAS u32x2_t*)(cs + (size_t)nt * 16 * 128) = wv; } \
          if (sl == 0 && n == 0) *(GAS f32x4*)(NST + (c) * 128 + 16 * w + 4 * fq) = accn; } \
        const LAS unsigned char* S = L + ((c) & 1) * SC_SLOT; const LAS unsigned char* Kt = S; const LAS unsigned char* Vt = S + SC_KT; const LAS float* wl = (const LAS float*)(S + SC_KT + SC_VT); \
        const float dec = __expf(mcs[c] - p63[c]); \
        _Pragma("unroll") for (int nt = 0; nt < SC_NT; ++nt) acc[nt] = acc[nt] * dec; \
        accn = accn * dec; \
        _Pragma("unroll") for (int ks = 0; ks < 2; ++ks) { \
            const s16x4 klo = tr4(Kt + kbase + ks * 32 * SC_KRS), khi = tr4(Kt + kbase + ks * 32 * SC_KRS + 4 * SC_KRS); \
            const f32x4 w0 = *(const LAS f32x4*)(wl + 32 * ks + 8 * fq), w1 = *(const LAS f32x4*)(wl + 32 * ks + 8 * fq + 4); \
            bf16x8 vf[SC_NT]; \
            _Pragma("unroll") for (int nt = 0; nt < SC_NT; ++nt) { const s16x4 a_ = tr4(Vt + vbase + nt * 32 + ks * 32 * SC_VRS), b_ = tr4(Vt + vbase + nt * 32 + ks * 32 * SC_VRS + 4 * SC_VRS); \
                vf[nt] = (bf16x8){a_[0], a_[1], a_[2], a_[3], b_[0], b_[1], b_[2], b_[3]}; } \
              \
            u32x4_t aw; aw.x = cvtpk(bf2f((bf16)klo[0]) * w0[0], bf2f((bf16)klo[1]) * w0[1]); aw.y = cvtpk(bf2f((bf16)klo[2]) * w0[2], bf2f((bf16)klo[3]) * w0[3]); \
            aw.z = cvtpk(bf2f((bf16)khi[0]) * w1[0], bf2f((bf16)khi[1]) * w1[1]); aw.w = cvtpk(bf2f((bf16)khi[2]) * w1[2], bf2f((bf16)khi[3]) * w1[3]); \
            const bf16x8 af = __builtin_bit_cast(bf16x8, aw); \
            accn = MLS_MFMA(af, onesf, accn); \
            _Pragma("unroll") for (int nt = 0; nt < SC_NT; ++nt) acc[nt] = MLS_MFMA(af, vf[nt], acc[nt]); } \
        if ((c) + 1 < 128) SC_STORE(RS, ((c) + 1) & 1); \
        __syncthreads(); } while (0)
    const int kbase = (8 * fq + (n >> 2)) * SC_KRS + (16 * w + 4 * (n & 3)) * 2, vbase = (8 * fq + (n >> 2)) * SC_VRS + (4 * (n & 3)) * 2;
    u32x4_t one_; one_.x = one_.y = one_.z = one_.w = (n == 0) ? 0x3f803f80u : 0u; const bf16x8 onesf = __builtin_bit_cast(bf16x8, one_);
    SC_LOAD(ra, 0); SC_LOAD(rb, 1); SC_LOAD(rc, 2); SC_LOAD(rd, 3);
    __syncthreads();
    SC_STORE(ra, 0);
    __syncthreads();
    for (int c = 0; c < 128; c += 4) { SC_STEP(c, ra, rb); SC_STEP(c + 1, rb, rc); SC_STEP(c + 2, rc, rd); SC_STEP(c + 3, rd, ra); }
#undef SC_LOAD
#undef SC_STORE
#undef SC_STEP
}

constexpr int OU_QRS = 272, OU_VRS = 528, OU_SRS = 144;
constexpr int OU_Q = 0, OU_K = OU_Q + 64 * OU_QRS, OU_V = OU_K + 64 * OU_QRS, OU_SW = OU_V + 64 * OU_VRS, OU_SC = OU_SW + 64 * OU_SRS;
struct OutPF { v4u q0, q1, k0, k1, vv[4]; bf16x8 cf[2][4]; float s0, s1, s2, mc; };
__device__ __forceinline__ void out_prefetch(OutPF& pf, const Args& args, int bh, int c, int tid) {
    const int lane = tid & 63, w = __builtin_amdgcn_readfirstlane(tid >> 6), n = lane & 15, fq = lane >> 4;
    const int b = bh >> 2, h = bh & 3; const size_t row0 = (size_t)b * 8192 + c * 64;
    const bf16* QMp = (const bf16*)(args.ws + WS_QM) + ((size_t)bh * 8192 + c * 64) * 128; const bf16* KMp = (const bf16*)(args.ws + WS_KM) + ((size_t)bh * 8192 + c * 64) * 128;
    const bf16* VMp = (const bf16*)(args.ws + WS_VM) + row0 * 1024 + h * 256;
    const bf16* CST = (const bf16*)args.out + ((size_t)bh * 128 + c) * 32768; const float* NST = (const float*)(args.ws + WS_NST) + ((size_t)bh * 128 + c) * 128;
    pf.q0 = *(const GAS v4u*)(QMp + tid * 8); pf.q1 = *(const GAS v4u*)(QMp + (tid + 512) * 8); pf.k0 = *(const GAS v4u*)(KMp + tid * 8); pf.k1 = *(const GAS v4u*)(KMp + (tid + 512) * 8);
#pragma unroll
    for (int i = 0; i < 4; ++i) { const int p = tid + 512 * i; pf.vv[i] = *(const GAS v4u*)(VMp + (size_t)(p >> 5) * 1024 + (p & 31) * 8); }
#pragma unroll
    for (int mi = 0; mi < 2; ++mi)
#pragma unroll
        for (int ks = 0; ks < 4; ++ks) pf.cf[mi][ks] = *(const GAS bf16x8*)(CST + (size_t)(32 * w + 16 * mi + n) * 128 + 32 * ks + 8 * fq);
    pf.s0 = 0.f; pf.s1 = 0.f; pf.s2 = 0.f;
    if (tid < 64) { const int t = bh * 8192 + c * 64 + tid; pf.s0 = ((const float*)(args.ws + WS_GPG))[t]; pf.s1 = ((const float*)(args.ws + WS_GPPM))[t]; pf.s2 = ((const float*)(args.ws + WS_GPB))[t]; }
    else if (tid < 192) pf.s0 = NST[tid - 64];
    pf.mc = ((const float*)(args.ws + WS_GPMC))[bh * 128 + c];
}
__device__ __forceinline__ void out_unit(const Args& args, LAS unsigned char* L, int bh, int c, int tid, OutPF& pf, bool has_next, int nbh, int nc, const size_t yoff = WS_YA) {
    const int lane = tid & 63, w = __builtin_amdgcn_readfirstlane(tid >> 6), n = lane & 15, fq = lane >> 4;
    const int b = bh >> 2, h = bh & 3; const size_t row0 = (size_t)b * 8192 + c * 64;
    const bf16* OGp = (const bf16*)(args.ws + WS_OG) + row0 * 1024 + h * 256;
    bf16* YAp = (bf16*)(args.ws + yoff) + row0 * 1024 + h * 256;
    LAS unsigned char* Qt = L + OU_Q; LAS unsigned char* Kt = L + OU_K; LAS unsigned char* Vt = L + OU_V; LAS unsigned char* SW = L + OU_SW;
    LAS float* gls = (LAS float*)(L + OU_SC); LAS float* pms = gls + 64; LAS float* bcs = pms + 64; LAS float* nvec = bcs + 64; LAS float* nqv = nvec + 128; LAS float* ssq = nqv + 64;
    const f32x4 Z4 = {0.f, 0.f, 0.f, 0.f};
    __syncthreads();
    const float mc = pf.mc;
    *(LAS v4u*)(Qt + (tid >> 4) * OU_QRS + (tid & 15) * 16) = pf.q0; *(LAS v4u*)(Qt + ((tid + 512) >> 4) * OU_QRS + (tid & 15) * 16) = pf.q1;
    *(LAS v4u*)(Kt + (tid >> 4) * OU_QRS + (tid & 15) * 16) = pf.k0; *(LAS v4u*)(Kt + ((tid + 512) >> 4) * OU_QRS + (tid & 15) * 16) = pf.k1;
#pragma unroll
    for (int i = 0; i < 4; ++i) { const int p = tid + 512 * i; *(LAS v4u*)(Vt + (p >> 5) * OU_VRS + (p & 31) * 16) = pf.vv[i]; }
    if (tid < 64) { gls[tid] = pf.s0; pms[tid] = fmaxf(mc, pf.s1); bcs[tid] = pf.s2; }
    else if (tid < 192) nvec[tid - 64] = pf.s0;
    bf16x8 cf[2][4];
#pragma unroll
    for (int mi = 0; mi < 2; ++mi)
#pragma unroll
        for (int ks = 0; ks < 4; ++ks) cf[mi][ks] = pf.cf[mi][ks];
    u32x2_t ogr[4][2];
#pragma unroll
    for (int nt = 0; nt < 4; ++nt)
#pragma unroll
        for (int mi = 0; mi < 2; ++mi) ogr[nt][mi] = *(const GAS u32x2_t*)(OGp + (size_t)(16 * nt + n) * 1024 + 32 * w + 16 * mi + 4 * fq);
    f32x4 gvr[2];
    { const float* ng0 = args.in[7] + h * 256;
#pragma unroll
      for (int mi = 0; mi < 2; ++mi) gvr[mi] = *(const GAS f32x4*)(ng0 + 32 * w + 16 * mi + 4 * fq); }
    if (has_next) out_prefetch(pf, args, nbh, nc, tid);
    __syncthreads();
#pragma unroll
    for (int k2 = 0; k2 < 2; ++k2) { const int idx = 2 * w + k2, mt = idx >> 2, nt = idx & 3;
        f32x4 sv = Z4;
        if (mt <= nt) {
#pragma unroll
            for (int ks = 0; ks < 4; ++ks) sv = MLS_MFMA(rowfrag(Kt, OU_QRS, 16 * mt + n, ks, lane), rowfrag(Qt, OU_QRS, 16 * nt + n, ks, lane), sv);
            const int t = 16 * nt + n; const float pmt = pms[t];
#pragma unroll
            for (int r = 0; r < 4; ++r) { const int s = 16 * mt + 4 * fq + r; sv[r] = (s <= t) ? sv[r] * __expf(gls[s] - pmt) : 0.f; }
        }
        u32x2_t wv; wv.x = cvtpk(sv[0], sv[1]); wv.y = cvtpk(sv[2], sv[3]);
        *(LAS u32x2_t*)(SW + (16 * nt + n) * OU_SRS + (16 * mt + 4 * fq) * 2) = wv; }
    __syncthreads();
    f32x4 acc[2][4], accx = Z4;
#pragma unroll
    for (int mi = 0; mi < 2; ++mi)
#pragma unroll
        for (int nt = 0; nt < 4; ++nt) acc[mi][nt] = Z4;
#pragma unroll
    for (int nt = 0; nt < 4; ++nt)
#pragma unroll
        for (int ks = 0; ks < 4; ++ks) { const bf16x8 qb = rowfrag(Qt, OU_QRS, 16 * nt + n, ks, lane);
            acc[0][nt] = MLS_MFMA(cf[0][ks], qb, acc[0][nt]); acc[1][nt] = MLS_MFMA(cf[1][ks], qb, acc[1][nt]); }
    if (w < 4) {
#pragma unroll
        for (int ks = 0; ks < 4; ++ks) { const f32x4 n0 = *(const LAS f32x4*)(nvec + 32 * ks + 8 * fq), n1 = *(const LAS f32x4*)(nvec + 32 * ks + 8 * fq + 4);
            u32x4_t pw; pw.x = cvtpk(n0[0], n0[1]); pw.y = cvtpk(n0[2], n0[3]); pw.z = cvtpk(n1[0], n1[1]); pw.w = cvtpk(n1[2], n1[3]);
            if (n != 0) { pw.x = 0u; pw.y = 0u; pw.z = 0u; pw.w = 0u; }
            accx = MLS_MFMA(__builtin_bit_cast(bf16x8, pw), rowfrag(Qt, OU_QRS, 16 * w + n, ks, lane), accx); }
        accx = accx * __expf(mc - pms[16 * w + n]);
    }
#pragma unroll
    for (int nt = 0; nt < 4; ++nt) { const float wi = __expf(mc - pms[16 * nt + n]); acc[0][nt] = acc[0][nt] * wi; acc[1][nt] = acc[1][nt] * wi; }
#pragma unroll
    for (int nt = 0; nt < 4; ++nt)
#pragma unroll
        for (int ks = 0; ks < 2; ++ks) { if (32 * ks > 16 * nt + 15) continue;
            const bf16x8 sb = rowfrag(SW, OU_SRS, 16 * nt + n, ks, lane);
            acc[0][nt] = MLS_MFMA(trfrag_nat(Vt, OU_VRS, 32 * w, ks, lane), sb, acc[0][nt]);
            acc[1][nt] = MLS_MFMA(trfrag_nat(Vt, OU_VRS, 32 * w + 16, ks, lane), sb, acc[1][nt]); }
    if (w < 4) {
        u32x4_t one; one.x = one.y = one.z = one.w = (n == 0) ? 0x3f803f80u : 0u;
#pragma unroll
        for (int ks = 0; ks < 2; ++ks) accx = MLS_MFMA(__builtin_bit_cast(bf16x8, one), rowfrag(SW, OU_SRS, 16 * w + n, ks, lane), accx);
        if (fq == 0) nqv[16 * w + n] = accx[0];
    }
    __syncthreads();
#pragma unroll
    for (int nt = 0; nt < 4; ++nt) { const int t = 16 * nt + n; const float den = fmaxf(fabsf(nqv[t]), __expf(-(bcs[t] + pms[t]))), inv = 1.0f / den; float ss = 0.f;
#pragma unroll
        for (int mi = 0; mi < 2; ++mi) { acc[mi][nt] = acc[mi][nt] * inv;
#pragma unroll
            for (int r = 0; r < 4; ++r) ss += acc[mi][nt][r] * acc[mi][nt][r]; }
        ss += __shfl_xor(ss, 16); ss += __shfl_xor(ss, 32);
        if (fq == 0) ssq[w * 64 + t] = ss; }
    __syncthreads();
    const float* ng = args.in[7] + h * 256;
#pragma unroll
    for (int nt = 0; nt < 4; ++nt) { const int t = 16 * nt + n; float tot = 0.f;
#pragma unroll
        for (int ww = 0; ww < 8; ++ww) tot += ssq[ww * 64 + t];
        const float rs = 1.0f / sqrtf(tot * (1.f / 256.f) + RMS_EPS);
#pragma unroll
        for (int mi = 0; mi < 2; ++mi) { const int dv = 32 * w + 16 * mi + 4 * fq;
            const u32x2_t og = ogr[nt][mi]; const f32x4 gv = gvr[mi];
            const f32x4 hv = acc[mi][nt] * rs;
            u32x2_t wv; wv.x = cvtpk(hv[0] * gv[0] * bfl(og.x), hv[1] * gv[1] * bfh(og.x)); wv.y = cvtpk(hv[2] * gv[2] * bfl(og.y), hv[3] * gv[3] * bfh(og.y));
            *(GAS u32x2_t*)(YAp + (size_t)t * 1024 + dv) = wv; } }
}
#undef MLS_MFMA
}

constexpr size_t WS_W1T = 38 * MiB;
constexpr size_t WS_C1 = 512 * 1024;
constexpr size_t WS_W2T = 1 * MiB + 256 * 1024;
namespace cmpm {
using nsa::f32x4; using nsa::bf16x8; using nsa::u32x2_t; using nsa::cvtpk;
constexpr int HRS = 528, HOFF = 32 * 528;
__device__ __forceinline__ void cmp_unit(const Args& args, LAS unsigned char* L, int kind, int bg, int cb, int tid) {
    const int lane = tid & 63, w = __builtin_amdgcn_readfirstlane(tid >> 6), n = lane & 15, fq = lane >> 4;
    const bf16* A = (const bf16*)(args.ws + WS_NKV) + (size_t)kind * pg8::NKV_KIND_ELEMS + ((size_t)bg * 8192 + 16 * 32 * cb) * 64;
    const bf16* W1T = (const bf16*)(args.ws + WS_W1T) + (size_t)kind * 256 * 2048;
    const bf16* W2T = (const bf16*)(args.ws + WS_W2T) + (size_t)kind * 64 * 256;
    const float* c1 = (const float*)(args.ws + WS_C1) + kind * 256;
    bf16* dst = (bf16*)(args.ws + (kind ? WS_VCC : WS_KCC)) + ((size_t)bg * 512 + 32 * cb) * 64;
    const f32x4 Z4 = {0.f, 0.f, 0.f, 0.f};
    f32x4 acc[2][2] = {{Z4, Z4}, {Z4, Z4}};
    const bf16* wp0 = W1T + ((size_t)(2 * w) * 64 + lane) * 8; const bf16* wp1 = wp0 + 64 * 8;
    bf16x8 bw[2][8][2];
#pragma unroll
    for (int i = 0; i < 8; ++i) { bw[0][i][0] = *(const GAS bf16x8*)(wp0 + (size_t)i * 16 * 64 * 8); bw[0][i][1] = *(const GAS bf16x8*)(wp1 + (size_t)i * 16 * 64 * 8); }
    __syncthreads();
    for (int ch = tid; ch < 528 * 8; ch += 512) { const int r = ch >> 3, c16 = ch & 7;
        *(LAS v4u*)(L + HOFF + r * 128 + ((c16 ^ ((r >> 4) & 7)) << 4)) = *(const GAS v4u*)(A + (size_t)r * 64 + c16 * 8); }
    __syncthreads();
#pragma unroll
    for (int kb = 0; kb < 8; ++kb) {
        if (kb + 1 < 8) {
#pragma unroll
            for (int i = 0; i < 8; ++i) { const int ks = 8 * (kb + 1) + i; bw[(kb + 1) & 1][i][0] = *(const GAS bf16x8*)(wp0 + (size_t)ks * 16 * 64 * 8); bw[(kb + 1) & 1][i][1] = *(const GAS bf16x8*)(wp1 + (size_t)ks * 16 * 64 * 8); } }
#pragma unroll
        for (int i = 0; i < 8; ++i) { const int ks = 8 * kb + i; const bf16x8 b0 = bw[kb & 1][i][0], b1 = bw[kb & 1][i][1];
            const int r0 = 16 * n + (ks >> 1), r1 = r0 + 256, c16 = 4 * (ks & 1) + fq;
            const bf16x8 a0 = *(const LAS bf16x8*)(L + HOFF + r0 * 128 + ((c16 ^ ((r0 >> 4) & 7)) << 4)), a1 = *(const LAS bf16x8*)(L + HOFF + r1 * 128 + ((c16 ^ ((r1 >> 4) & 7)) << 4));
            acc[0][0] = __builtin_amdgcn_mfma_f32_16x16x32_bf16(b0, a0, acc[0][0], 0, 0, 0); acc[0][1] = __builtin_amdgcn_mfma_f32_16x16x32_bf16(b0, a1, acc[0][1], 0, 0, 0);
            acc[1][0] = __builtin_amdgcn_mfma_f32_16x16x32_bf16(b1, a0, acc[1][0], 0, 0, 0); acc[1][1] = __builtin_amdgcn_mfma_f32_16x16x32_bf16(b1, a1, acc[1][1], 0, 0, 0); }
    }
    __syncthreads();
#pragma unroll
    for (int nt = 0; nt < 2; ++nt) { const int col = 32 * w + 16 * nt + 4 * fq; const f32x4 cv = *(const GAS f32x4*)(c1 + col);
#pragma unroll
        for (int mt = 0; mt < 2; ++mt) { f32x4 v = acc[nt][mt] + cv;
#pragma unroll
            for (int r = 0; r < 4; ++r) v[r] = v[r] / (1.0f + __expf(-v[r]));
            u32x2_t wv; wv.x = cvtpk(v[0], v[1]); wv.y = cvtpk(v[2], v[3]);
            *(LAS u32x2_t*)(L + (16 * mt + n) * HRS + col * 2) = wv; } }
    __syncthreads();
    { const int mt2 = w >> 2, et = w & 3; f32x4 o = Z4;
#pragma unroll
      for (int ks = 0; ks < 8; ++ks) { const bf16x8 wa = *(const GAS bf16x8*)(W2T + (size_t)(16 * et + n) * 256 + 32 * ks + 8 * fq);
          const bf16x8 hb = *(const LAS bf16x8*)(L + (16 * mt2 + n) * HRS + ks * 64 + fq * 16);
          o = __builtin_amdgcn_mfma_f32_16x16x32_bf16(wa, hb, o, 0, 0, 0); }
      u32x2_t wv; wv.x = cvtpk(o[0], o[1]); wv.y = cvtpk(o[2], o[3]);
      *(GAS u32x2_t*)(dst + (size_t)(16 * mt2 + n) * 64 + 16 * et + 4 * fq) = wv; }
}
}
#ifndef REP_MASK
#define REP_MASK 0
#endif
#ifndef P1_ALIGN
#define P1_ALIGN true
#endif
__global__ void __launch_bounds__(NWAVES * 64, 2) mk_fwd(Args args) {
    extern __shared__ __attribute__((aligned(16))) unsigned char lds[];
    LAS unsigned char* L = (LAS unsigned char*)lds;
    volatile LAS unsigned* MISCW = (volatile LAS unsigned*)(L + MISC_OFF);
    const int tid = threadIdx.x, lane = tid & 63, wave = __builtin_amdgcn_readfirstlane(tid >> 6);
    const int G = gridDim.x; const int bx = blockIdx.x; const int vcu = (G % 8 == 0) ? (bx % 8) * (G / 8) + bx / 8 : bx;
    unsigned char* ws = args.ws;
    gu32* ctl = (gu32*)(ws + WS_CTL);
    for (int u = tid; u < (LDS_BYTES - LDSCTL_OFF) / 4; u += NWAVES * 64) ((LAS unsigned*)(L + LDSCTL_OFF))[u] = 0u;
    __syncthreads();
    const int lo = args.ph_lo, hi = args.ph_hi;
    XcdBarrier bar; bar.bar = (unsigned*)(ctl + CW_BAR); bar.x = 0; bar.st = nullptr;
    if (hi - lo > 1) bar = xcd_barrier_post((unsigned*)(ctl + CW_BAR), MISCW + 8);
#define IN(k) (lo <= (k) && (k) < hi)
#define SEAM(k) do { if (IN(k) && IN((k) + 1)) xcd_barrier(bar); } while (0)

    const float* x = args.in[0];
    bf16* Wt_in = (bf16*)(ws + WS_WIN); bf16* WaT = (bf16*)(ws + WS_WA); bf16* WbT = (bf16*)(ws + WS_WB); bf16* WoT = (bf16*)(ws + WS_WO);
    bf16* WguT = (bf16*)(ws + WS_WGU); bf16* WdT = (bf16*)(ws + WS_WD);
    float* biasp = (float*)(ws + WS_BIASP); float* MISCB = (float*)(ws + WS_MISC);
    float* ssq1 = (float*)(ws + WS_SSQ1); float* ssq2 = (float*)(ws + WS_SSQ2);
    bf16* XN = (bf16*)(ws + WS_XN); bf16* QKR = (bf16*)args.out;     bf16* VM = (bf16*)(ws + WS_VM); bf16* OG = (bf16*)(ws + WS_OG);
    bf16* NQ = (bf16*)(ws + WS_NQ); bf16* NKV = (bf16*)(ws + WS_NKV); bf16* GA = (bf16*)(ws + WS_GA); bf16* GB = (bf16*)(ws + WS_GB);
    bf16* QM = (bf16*)(ws + WS_QM); bf16* KM = (bf16*)(ws + WS_KM);
    bf16* YA = (bf16*)(ws + WS_YA); bf16* YB = (bf16*)(ws + WS_YB); bf16* T1 = (bf16*)(ws + WS_T1); bf16* MERGED = (bf16*)(ws + WS_MERGED);
    bf16* X1B = (bf16*)(ws + WS_X1B); bf16* ACT = (bf16*)(ws + WS_ACT);
    float* OUT = args.out;
    const int gw = vcu * NWAVES + wave, NGW = G * NWAVES;
    const int gt = vcu * (NWAVES * 64) + tid, NGT = G * NWAVES * 64;

    if (IN(0)) for (int rep0 = 0; rep0 < ((REP_MASK & 1) ? 2 : 1); ++rep0) {
        if (rep0) xcd_barrier(bar);
        LAS float* scr = (LAS float*)(L + wave * 16384);
        const float* w_in = args.in[2]; const float* g1 = args.in[1]; const float* g2 = args.in[17];
        constexpr int I0 = 16 * 96, I1 = 16 * 16, I2 = 16 * 24, I3 = 16 * 64, I4 = 16 * 32, I5 = 8 * 32, I6 = 16 * 32, I7 = 16 * 88, I8 = 16 * 88, I9 = 44 * 32;
        constexpr int NITEMS = I0 + I1 + I2 + I3 + I4 + I5 + I6 + I7 + I8 + I9 + 256 + 256 + 8 + 8;
        for (int it = gw; it < ((rep0 && (REP_MASK & 0x2000)) ? 0 : NITEMS); it += NGW) {
            int r = it;
            if (r < I0) { tr_item<0>(w_in, IN_W, 0, 1024, Wt_in, 0, g1, scr, r / 96, r % 96, lane); continue; } r -= I0;
            if (r < I1) { tr_item<0>(w_in, IN_W, 3080, 1024, Wt_in, 3072, g1, scr, r / 16, r % 16, lane); continue; } r -= I1;
            if (r < I2) { tr_item<0>(w_in, IN_W, 3592, 1024, Wt_in, 3584, g1, scr, r / 24, r % 24, lane); continue; } r -= I2;
            if (r < I3) { tr_item<0>(w_in, IN_W, 4384, 1024, Wt_in, 4352, g1, scr, r / 64, r % 64, lane); continue; } r -= I3;
            if (r < I4) { tr_item<0>(args.in[14], 1024, 0, 1024, WaT, 0, nullptr, scr, r / 32, r % 32, lane); continue; } r -= I4;
            if (r < I5) { tr_item<0>(args.in[15], 1024, 0, 512, WbT, 0, nullptr, scr, r / 32, r % 32, lane); continue; } r -= I5;
            if (r < I6) { tr_item<0>(args.in[16], 1024, 0, 1024, WoT, 0, nullptr, scr, r / 32, r % 32, lane); continue; } r -= I6;
            if (r < I7) { tr_item<1>(args.in[18], FF, 0, 1024, WguT, 0, g2, scr, r / 88, r % 88, lane); continue; } r -= I7;
            if (r < I8) { tr_item<1>(args.in[19], FF, 0, 1024, WguT, 128, g2, scr, r / 88, r % 88, lane); continue; } r -= I8;
            if (r < I9) { tr_item<0>(args.in[20], 1024, 0, FF, WdT, 0, nullptr, scr, r / 32, r % 32, lane); continue; } r -= I9;
            if (r < 256) { tr_item<2>(args.in[9], 256, 0, 2048, (bf16*)(ws + WS_W1T), 256, nullptr, scr, r / 8, r % 8, lane); continue; } r -= 256;
            if (r < 256) { tr_item<2>(args.in[12], 256, 0, 2048, (bf16*)(ws + WS_W1T) + 256 * 2048, 256, nullptr, scr, r / 8, r % 8, lane); continue; } r -= 256;
            if (r < 8) { tr_item<0>(args.in[10], 64, 0, 256, (bf16*)(ws + WS_W2T), 0, nullptr, scr, r / 2, r % 2, lane); continue; } r -= 8;
            tr_item<0>(args.in[13], 64, 0, 256, (bf16*)(ws + WS_W2T) + 64 * 256, 0, nullptr, scr, r / 2, r % 2, lane);
        }
        if (G == 256 && rep0 == 0) {
            const int kind = tid >> 8, j = tid & 255; const float* pos = args.in[kind ? 11 : 8]; const float* w1 = args.in[kind ? 12 : 9]; float pv[8], wv[8];
#pragma unroll
            for (int i = 0; i < 8; ++i) { pv[i] = pos[8 * vcu + i]; wv[i] = w1[(size_t)(8 * vcu + i) * 256 + j]; }
            float a = 0.f;
#pragma unroll
            for (int i = 0; i < 8; ++i) a += pv[i] * wv[i];
            atomicAdd((float*)(ws + WS_C1) + kind * 256 + j, a); }
        else if (vcu < 64 && rep0 == 0) { const int kind = tid >> 8, j = tid & 255; const float* pos = args.in[kind ? 11 : 8]; const float* w1 = args.in[kind ? 12 : 9]; float a = 0.f;
#pragma unroll 8
            for (int i = 32 * vcu; i < 32 * vcu + 32; ++i) a += pos[i] * w1[(size_t)i * 256 + j];
            atomicAdd((float*)(ws + WS_C1) + kind * 256 + j, a); }
        if (!rep0) for (int idx = gt; idx < 256 * 1024; idx += NGT) { const int r = idx >> 10, k = idx & 1023;
            float v = 0.f; if (r < 32) v = w_in[(size_t)k * IN_W + misc_src_col(r)] * g1[k];
            Wt_in[(size_t)(6400 + r) * 1024 + k] = (bf16)f2bf(v); }
        if (!rep0) for (int n = gt; n < NIN; n += NGT) biasp[n] = (n < IN_W) ? args.in[3][inproj_src_col(n)] : 0.f;
        {   const int mend = (rep0 && (REP_MASK & 0x1000)) ? 0 : TOK;
            int m0 = gw * 4; f32x4 v[4][4];
            if (m0 < mend) {
#pragma unroll
                for (int r = 0; r < 4; ++r) { const GAS f32x4* xr = (const GAS f32x4*)(x + (size_t)(m0 + r) * DM) + lane;
#pragma unroll
                    for (int j = 0; j < 4; ++j) v[r][j] = xr[64 * j]; } }
            while (m0 < mend) {
                const int m1 = m0 + NGW * 4; f32x4 vn[4][4];
#pragma unroll
                for (int r = 0; r < 4; ++r)
#pragma unroll
                    for (int j = 0; j < 4; ++j) vn[r][j] = v[r][j];
                if (m1 < mend) {
#pragma unroll
                    for (int r = 0; r < 4; ++r) { const GAS f32x4* xr = (const GAS f32x4*)(x + (size_t)(m1 + r) * DM) + lane;
#pragma unroll
                        for (int j = 0; j < 4; ++j) vn[r][j] = xr[64 * j]; } }
                float s[4];
#pragma unroll
                for (int r = 0; r < 4; ++r) { s[r] = 0.f;
#pragma unroll
                    for (int j = 0; j < 4; ++j) s[r] += (v[r][j].x * v[r][j].x + v[r][j].y * v[r][j].y) + (v[r][j].z * v[r][j].z + v[r][j].w * v[r][j].w); }
#pragma unroll
                for (int o = 1; o < 64; o <<= 1) {
#pragma unroll
                    for (int r = 0; r < 4; ++r) s[r] += __shfl_xor(s[r], o); }
#pragma unroll
                for (int r = 0; r < 4; ++r) { const float rs = 1.0f / sqrtf(s[r] * (1.f / DM) + RMS_EPS);
                    const int tt = (m0 + r) & 255, prow = ((m0 + r) & ~255) + ((tt >> 7) * 64 + ((tt >> 3) & 15) + ((tt >> 2) & 1) * 128 + (tt & 3) * 16);
                    GAS unsigned long long* o8 = (GAS unsigned long long*)(XN + (size_t)prow * DM) + lane;
#pragma unroll
                    for (int j = 0; j < 4; ++j) o8[64 * j] = (unsigned long long)pk2(v[r][j].x * rs, v[r][j].y * rs) | ((unsigned long long)pk2(v[r][j].z * rs, v[r][j].w * rs) << 32); }
                m0 = m1;
#pragma unroll
                for (int r = 0; r < 4; ++r)
#pragma unroll
                    for (int j = 0; j < 4; ++j) v[r][j] = vn[r][j];
            } }
        SEAM(0);
    }
    if (IN(1)) {
        pg8::Gemm g{XN, Wt_in, TOK, NIN, DM}; pg8::StaticOrder S; S.init(TOK, NIN, G, bx);
        {   float2 bq[(NIN / 2 + NWAVES * 64 - 1) / (NWAVES * 64)];
#pragma unroll
            for (int k = 0; k < (NIN / 2 + NWAVES * 64 - 1) / (NWAVES * 64); ++k) { const int i = tid + k * NWAVES * 64; bq[k] = (i < NIN / 2) ? *(const float2*)(biasp + 2 * i) : make_float2(0.f, 0.f); }
#pragma unroll
            for (int k = 0; k < (NIN / 2 + NWAVES * 64 - 1) / (NWAVES * 64); ++k) { const int i = tid + k * NWAVES * 64; if (i < NIN / 2) ((LAS unsigned*)(L + 132096))[i] = pk2(bq[k].x, bq[k].y); } }
        __syncthreads();
        pg8::EpiInProj E{L + 132096, QM, KM, args.in[5], args.in[6], QKR, VM, OG, NQ, NKV, GA, GB, MISCB};
#ifndef P1_STAGGER
#define P1_STAGGER 0
#endif
        if (vcu & 1) { for (int k = 0; k < P1_STAGGER; ++k) __builtin_amdgcn_s_sleep(127); }
        pg8::gemm_phase<pg8::EpiInProj, pg8::StaticOrder, P1_ALIGN, true>(L, g, S, E);
#if REP_MASK & 2
        xcd_barrier(bar);
        if (REP_MASK & 0x100) { pg8::EpiPlain EP{(bf16*)(ws + 48 * MiB), 1024}; pg8::gemm_phase<pg8::EpiPlain, pg8::StaticOrder, true, true>(L, g, S, EP); }
        else pg8::gemm_phase<pg8::EpiInProj, pg8::StaticOrder, true, true>(L, g, S, E);
#endif
        SEAM(1);
    }
    if (IN(2)) for (int rep2 = 0; rep2 < ((REP_MASK & 4) ? 2 : 1); ++rep2) {
        if (rep2) xcd_barrier(bar);
        const float* cw = args.in[5]; const float* cb = args.in[6];
        constexpr int NCMP = 64;
        const int gt2 = (vcu - NCMP) * (NWAVES * 64) + tid, NGT2 = (G - NCMP) * NWAVES * 64, gw2 = (vcu - NCMP) * NWAVES + wave, NGW2 = (G - NCMP) * NWAVES;
        for (int item = gt; item < 256 * 128; item += NGT) {
            const int blk = item >> 7, cg = item & 127, c0 = cg * 8, r0 = blk * 128, b = r0 >> 13, t0 = r0 & 8191;
            float w[4][8], bs[8], xr[6][8];
#pragma unroll
            for (int j = 0; j < 4; ++j)
#pragma unroll
                for (int i = 0; i < 8; ++i) w[j][i] = cw[j * 1024 + c0 + i];
#pragma unroll
            for (int i = 0; i < 8; ++i) bs[i] = cb[c0 + i];
#pragma unroll
            for (int k = 0; k < 6; ++k) { v4u a = {0u, 0u, 0u, 0u}; if (k >= 3 || t0 > 0) a = *(const GAS v4u*)(QKR + ((size_t)blk * 6 + k) * 1024 + c0);
                xr[k][0] = bfl(a.x); xr[k][1] = bfh(a.x); xr[k][2] = bfl(a.y); xr[k][3] = bfh(a.y); xr[k][4] = bfl(a.z); xr[k][5] = bfh(a.z); xr[k][6] = bfl(a.w); xr[k][7] = bfh(a.w); }
            const bool isk = c0 >= 512; const int cc = isk ? c0 - 512 : c0, h = cc >> 7, d = cc & 127;
            bf16* dst = (isk ? KM : QM) + ((size_t)((b * 4 + h) * 8192 + t0)) * 128 + d;
            const float osc = isk ? 0.08838834764831845f : 1.0f;
#pragma unroll
            for (int j = 0; j < 3; ++j) { float y[8];
#pragma unroll
                for (int i = 0; i < 8; ++i) { float v = bs[i] + w[0][i] * xr[j][i] + w[1][i] * xr[j + 1][i] + w[2][i] * xr[j + 2][i] + w[3][i] * xr[j + 3][i]; y[i] = v * sigm(v) * osc; }
                v4u o; o.x = pk2(y[0], y[1]); o.y = pk2(y[2], y[3]); o.z = pk2(y[4], y[5]); o.w = pk2(y[6], y[7]);
                *(GAS v4u*)(dst + (size_t)j * 128) = o; }
        }
        for (int ch0 = gt; ch0 < 8 * 128 * 8 * 64; ch0 += 4 * NGT) {
            v4u kq[4]; unsigned short e8[4][8];
#pragma unroll
            for (int q = 0; q < 4; ++q) { const int ch = (ch0 + q * NGT < 8 * 128 * 8 * 64) ? ch0 + q * NGT : ch0; const int ln = ch & 63, fr = (ch >> 6) & 7, blk = ch >> 9;
                const bf16* ks = NKV + (size_t)2 * pg8::NKV_KIND_ELEMS + (size_t)blk * 4096; const bf16* vs = NKV + (size_t)3 * pg8::NKV_KIND_ELEMS + (size_t)blk * 4096;
                const int i16 = ln & 15, fq4 = ln >> 4;
                { const int mt = fr >> 1, ks2 = fr & 1; kq[q] = *(const GAS v4u*)(ks + (16 * mt + i16) * 64 + 32 * ks2 + 8 * fq4); }
                { const int dt = fr >> 1, jj = fr & 1;
#pragma unroll
                  for (int e = 0; e < 8; ++e) e8[q][e] = vs[(32 * jj + 16 * (e >> 2) + 4 * fq4 + (e & 3)) * 64 + 16 * dt + i16]; } }
#pragma unroll
            for (int q = 0; q < 4; ++q) { const int ch = (ch0 + q * NGT < 8 * 128 * 8 * 64) ? ch0 + q * NGT : ch0; const int blk = ch >> 9;
                *(GAS v4u*)((bf16*)(ws + WS_KSF) + (size_t)ch * 8) = kq[q];
                v4u o; o.x = e8[q][0] | ((unsigned)e8[q][1] << 16); o.y = e8[q][2] | ((unsigned)e8[q][3] << 16); o.z = e8[q][4] | ((unsigned)e8[q][5] << 16); o.w = e8[q][6] | ((unsigned)e8[q][7] << 16);
                *(GAS v4u*)((bf16*)(ws + WS_VSF) + (size_t)ch * 8) = o;
                float vm = 0.f;
#pragma unroll
                for (int e = 0; e < 8; ++e) vm = fmaxf(vm, fabsf(bf2f(e8[q][e])));
                vm = wave_max(vm);
                if (lane == 0) { unsigned* vp = (unsigned*)(ws + WS_VMAX) + (blk >> 7); if (__float_as_uint(vm) > __hip_atomic_load(vp, RLX_AGENT)) atomicMax(vp, __float_as_uint(vm)); } } }
        for (int u = gw; u < 2048; u += NGW) mls::gate_chunk(args, u >> 7, u & 127, lane);
        for (int u = vcu; u < 256; u += G) cmpm::cmp_unit(args, L, u >> 7, (u >> 4) & 7, u & 15, tid);
#ifdef SELF_CHECK
        xcd_barrier(bar);
        { const int sub = tid >> 8, stid = tid & 255; LAS unsigned char* Ls = L + sub * 65536;
          for (int it = vcu * 2 + sub; it < 8192; it += 2 * G) cmp_item(args, Ls, it < 8176 ? it : 8175, stid, 45 * MiB, 45 * MiB + 512 * 1024); }
        xcd_barrier(bar);
        { float md = 0.f; const bf16* a = (const bf16*)(ws + WS_KCC); const bf16* r = (const bf16*)(ws + 45 * MiB);
          for (int i = gt; i < 2 * 8 * 512 * 64; i += NGT) { const int cc = (i >> 6) & 511; if (cc < 511) md = fmaxf(md, fabsf(bf2f(a[i]) - bf2f(r[i]))); }
          md = wave_max(md); if (lane == 0) atomicMax((unsigned*)(ctl + 24), __float_as_uint(md)); }
#endif
        SEAM(2);
    }
    if (IN(3)) {
#ifdef SELF_CHECK
        { const int sub = tid >> 8, stid = tid & 255; LAS unsigned char* Ls = L + sub * 65536; const int NS = 2 * G, niter = (65536 + NS - 1) / NS;
          for (int k = 0; k < niter; ++k) { const int it = k * NS + vcu * 2 + sub; nsa_scalar_item(args, Ls, it < 65536 ? it : 65535, stid, it < 65536, (bf16*)(ws + 144 * MiB)); } }
        xcd_barrier(bar);
#endif
        { const bool spread = false; const int sid = spread ? (((vcu & 31) < 4) ? (vcu >> 5) * 4 + (vcu & 31) : -1) : (vcu < 32 ? vcu : -1);
          if (sid >= 0) { mls::state_scan(args, L, sid >> 1, sid & 1, tid);
              asm volatile("s_waitcnt vmcnt(0)" ::: "memory"); __syncthreads();
              if (tid == 0) { __builtin_amdgcn_fence(__ATOMIC_RELEASE, "agent"); asm volatile("s_waitcnt vmcnt(0)" ::: "memory"); (void)xb_add((unsigned*)(ctl + 184), 1u); } } }
        { const unsigned myx = xb_xcc_id() & 7u;
          for (;;) {
            __syncthreads();
            if (tid == 0) { unsigned r = 0xFFFFFFFFu;
                for (unsigned k = 0; k < 8u; ++k) { const unsigned qx = (myx + k) & 7u; gu32* qc = ctl + 32 + 16 * qx;
                    if (__hip_atomic_load(qc, RLX_AGENT) >= 128u) continue;
                    const unsigned v = __hip_atomic_fetch_add(qc, 1u, RLX_AGENT);
                    if (v < 128u) { r = qx | ((127u - v) << 3); break; } }
                MISCW[16] = r; }
            __syncthreads();
            const unsigned r = MISCW[16];
            if (r == 0xFFFFFFFFu) break;
            nsa::nsa_unit(args, L, (int)(r & 7u), (int)(r >> 3), tid);
          } }
#ifndef MERGE34
#define MERGE34 1
#endif
        if (MERGE34 && IN(4)) {
            if (tid == 0) { XB_SPIN(xb_ld((unsigned*)(ctl + 184)) < 32u, (unsigned*)(ctl + CW_BAR)); __builtin_amdgcn_fence(__ATOMIC_ACQUIRE, "agent"); asm volatile("s_waitcnt vmcnt(0)" ::: "memory"); }
            __syncthreads();
            if (tid == 0) MISCW[16] = xb_add((unsigned*)(ctl + 168), 1u);
            __syncthreads();
            int u = (int)MISCW[16];
            if (u < 2048) { mls::OutPF pf; mls::out_prefetch(pf, args, u >> 7, u & 127, tid);
                for (;;) { __syncthreads(); if (tid == 0) MISCW[16] = xb_add((unsigned*)(ctl + 168), 1u); __syncthreads(); const int un = (int)MISCW[16];
                    mls::out_unit(args, L, u >> 7, u & 127, tid, pf, un < 2048, un >> 7, un & 127);
                    if (un >= 2048) break; u = un; } }
        }
#ifdef SELF_CHECK
        xcd_barrier(bar);
        { float md = 0.f; const bf16* r = (const bf16*)(ws + 144 * MiB);
          for (size_t i = gt; i < (size_t)TOK * 512; i += NGT) md = fmaxf(md, fabsf(bf2f(YB[i]) - bf2f(r[i])));
          md = wave_max(md); if (lane == 0) atomicMax((unsigned*)(ctl + 25), __float_as_uint(md)); }
#endif
#if REP_MASK & 8
        xcd_barrier(bar);
        if (vcu < 32) { if (REP_MASK & 0x10000) mls::state_scan(args, L, vcu >> 1, vcu & 1, tid); }
        else if (vcu >= 64) { if (REP_MASK & 0x20000) for (int u = vcu - 64; u < 1024; u += G - 64) nsa::nsa_unit(args, L, u & 7, 127 - (u >> 3), tid, (REP_MASK >> 20) & 511, 144 * MiB); }
#endif
        if (!(MERGE34 && IN(4))) SEAM(3);
    }
#if REP_MASK & 0x200
    xcd_barrier(bar); xcd_barrier(bar); xcd_barrier(bar); xcd_barrier(bar);
#endif
    if (IN(4)) {
        if (!(MERGE34 && IN(3)))
        { mls::OutPF pf; mls::out_prefetch(pf, args, vcu >> 7, vcu & 127, tid);
          for (int u = vcu; u < 2048; u += G) { const int un = u + G; mls::out_unit(args, L, u >> 7, u & 127, tid, pf, un < 2048, un >> 7, un & 127); } }
        SEAM(4);
    }
    if (IN(5)) {
        { pg8::Gemm g{YA, WaT, TOK, DM, DM}; pg8::StaticOrder S; S.init(TOK, DM, G, bx);
          pg8::EpiGateMul<false> E{GA, nullptr, T1};
          pg8::gemm_phase<pg8::EpiGateMul<false>, pg8::StaticOrder, true, true>(L, g, S, E); }
        asm volatile("s_waitcnt vmcnt(0)" ::: "memory"); __syncthreads();
        { pg8::Gemm g{YB, WbT, TOK, DM, 512}; pg8::StaticOrder S; S.init(TOK, DM, G, bx);
          pg8::EpiGateMul<true> E{GB, T1, MERGED};
          pg8::gemm_phase<pg8::EpiGateMul<true>, pg8::StaticOrder, true, true>(L, g, S, E); }
        SEAM(5);
    }
    if (IN(6)) {
        pg8::Gemm g{MERGED, WoT, TOK, DM, DM}; pg8::StaticOrder S; S.init(TOK, DM, G, bx);
        pg8::EpiResidual<true> E{x, X1B, ssq1};
        pg8::gemm_phase<pg8::EpiResidual<true>, pg8::StaticOrder, true, true>(L, g, S, E);
        SEAM(6);
    }
    if (IN(7)) {
        pg8::Gemm g{X1B, WguT, TOK, 2 * FF, DM}; pg8::StaticOrder S; S.init(TOK, 2 * FF, G, bx);
        pg8::EpiSwiGLU E{ssq1, ACT};
        pg8::gemm_phase<pg8::EpiSwiGLU, pg8::StaticOrder, true, true>(L, g, S, E);
#if REP_MASK & 128
        xcd_barrier(bar); pg8::gemm_phase<pg8::EpiSwiGLU, pg8::StaticOrder, true, true>(L, g, S, E);
#endif
        SEAM(7);
    }
    if (IN(8)) {
        pg8::Gemm g{ACT, WdT, TOK, DM, FF}; pg8::StaticOrder S; S.init(TOK, DM, G, bx);
#ifndef FUSE_FNORM
#define FUSE_FNORM 1
#endif
#if FUSE_FNORM
        pg8::EpiResidNormF E{X1B, args.in[21], OUT, (float*)(ws + WS_KCC), (unsigned*)(ctl + 512), L + 132096};
        pg8::gemm_phase<pg8::EpiResidNormF, pg8::StaticOrder, true, true>(L, g, S, E);
#else
        pg8::EpiResidual<false> E{X1B, T1, ssq2};
        pg8::gemm_phase<pg8::EpiResidual<false>, pg8::StaticOrder, true, true>(L, g, S, E);
        SEAM(8);
#endif
    }
    if (IN(9) && !FUSE_FNORM) {
        const float* gf = args.in[21];
        for (int idx = gt; idx < TOK * 256; idx += NGT) { const int row = idx >> 8, c4 = idx & 255;
            const float r = 1.0f / sqrtf(ssq2[row] * (1.f / DM) + RMS_EPS);
            const unsigned long long xw = *((const GAS unsigned long long*)(T1 + (size_t)row * DM) + c4); const f32x4 gv = *((const GAS f32x4*)gf + c4);
            f32x4 v; v.x = bfl((unsigned)xw); v.y = bfh((unsigned)xw); v.z = bfl((unsigned)(xw >> 32)); v.w = bfh((unsigned)(xw >> 32));
            *((GAS f32x4*)(OUT + (size_t)row * DM) + c4) = v * r * gv; }
#ifdef SELF_CHECK
        if (gt == 0) { VM_WAIT(); OUT[0] += 1e3f * __uint_as_float(__hip_atomic_load(ctl + 24 + (SELF_CHECK), RLX_AGENT)); }
#endif
#ifdef DIAG_SEL
        if (gt == 0) { VM_WAIT(); const unsigned* dg = (const unsigned*)(ws + 768 * 1024); const float nn = (float)__hip_atomic_load((gu32*)dg + 3, RLX_AGENT);
            OUT[0] += 16.0f * (float)__hip_atomic_load((gu32*)dg + (DIAG_SEL), RLX_AGENT) / nn * 0.1f; }
#endif
    }
#undef IN
#undef SEAM
}

extern "C" void kernel_launch(void* const* d_in, const int* in_sizes, int n_in, void* d_out, int out_size, void* d_ws, size_t ws_size, hipStream_t stream) {
    static int grid = 0;
    if (grid == 0) {
        if (n_in != 22 || in_sizes[0] != TOK * DM || out_size != TOK * DM || ws_size < WS_END) {
            fprintf(stderr, "kernel_launch: unexpected shapes: n_in %d in0 %d out %d ws %zu\n", n_in, n_in > 0 ? in_sizes[0] : -1, out_size, ws_size); grid = -1; return; }
        int dev = 0, cus = 0;
        if (hipGetDevice(&dev) != hipSuccess || hipDeviceGetAttribute(&cus, hipDeviceAttributeMultiprocessorCount, dev) != hipSuccess) { grid = -1; return; }
        if (hipFuncSetAttribute((const void*)mk_fwd, hipFuncAttributeMaxDynamicSharedMemorySize, LDS_BYTES) != hipSuccess) { fprintf(stderr, "kernel_launch: hipFuncSetAttribute failed\n"); grid = -1; return; }
        int per_cu = 0;
        if (hipOccupancyMaxActiveBlocksPerMultiprocessor(&per_cu, (const void*)mk_fwd, NWAVES * 64, LDS_BYTES) != hipSuccess || per_cu < 1) fprintf(stderr, "kernel_launch: occupancy query says %d\n", per_cu);
        (void)hipGetLastError();
        grid = cus;
    }
    if (grid < 0) return;
    (void)hipMemsetAsync((char*)d_ws + WS_CTL, 0, CTL_ZERO_BYTES, stream);
    Args a{};
    for (int i = 0; i < 22; ++i) a.in[i] = (const float*)d_in[i];
    a.out = (float*)d_out; a.ws = (unsigned char*)d_ws;
    auto run = [&](int lo, int hi) { a.ph_lo = lo; a.ph_hi = hi; hipLaunchKernelGGL(mk_fwd, dim3(grid), dim3(NWAVES * 64), LDS_BYTES, stream, a); };
    run(0, 10);
}
```
